# Optimizing an MI355X kernel written in HIP

```python
import math
import jax, jax.numpy as jnp
from jax import lax
import numpy as np

D_MODEL = 1024
BATCH = 8
SEQ = 2048
DEPTH = 1
DEC_BATCH = 128
DEC_SEQ = 4
PAST_LEN = 2048
PAGE_SIZE = 128

D_MIX = D_MODEL
HEAD_DIM = 128
GDN_HEADS = D_MIX // (2 * HEAD_DIM)
FOX_HEADS = D_MIX // (2 * HEAD_DIM)
GDN_DK = HEAD_DIM
GDN_DV = HEAD_DIM
GDN_KEY_W = GDN_HEADS * GDN_DK
GDN_WIDTH = GDN_HEADS * GDN_DV
FOX_WIDTH = FOX_HEADS * HEAD_DIM
GDN_CONV_DIM = 2 * GDN_KEY_W + GDN_WIDTH
CONV_K = 4
GDN_CHUNK = 64
Q_BLOCK = 128
NORM_EPS = 1e-6
L2_EPS = 1e-6
FGATE_BIAS_MEAN = 3.0
SPLIT_SIZES = (GDN_CONV_DIM, GDN_WIDTH, GDN_HEADS, GDN_HEADS, FOX_WIDTH, FOX_WIDTH, FOX_WIDTH, FOX_WIDTH, FOX_HEADS)
D_IN = sum(SPLIT_SIZES)

kernel_name = 'hymba_gdn_fox_decode_step'


def rms_norm(x, w):
    xf = x.astype(jnp.float32)
    y = xf * lax.rsqrt(jnp.mean(xf * xf, axis=-1, keepdims=True) + NORM_EPS)
    return (y * w.astype(jnp.float32)).astype(x.dtype)


def l2_normalize(x):
    return x * lax.rsqrt(jnp.sum(x * x, axis=-1, keepdims=True) + L2_EPS)


def split_proj(p):
    idx = [int(i) for i in np.cumsum(SPLIT_SIZES)[:-1]]
    return jnp.split(p, idx, axis=-1)


def short_conv(x, buf, w):
    L = x.shape[1]
    xx = jnp.concatenate([buf.astype(x.dtype), x], axis=1)
    y = sum(xx[:, j:j + L] * w[j] for j in range(CONV_K))
    return jax.nn.silu(y), xx[:, -(CONV_K - 1):]


def gdn_chunked(q, k, v, g, beta, s0):
    B, L, H, DK = q.shape
    DV = v.shape[-1]
    C = min(GDN_CHUNK, L)
    n = -(-L // C)
    pad = n * C - L
    if pad:
        pad4 = ((0, 0), (0, pad), (0, 0), (0, 0))
        q, k, v = jnp.pad(q, pad4), jnp.pad(k, pad4), jnp.pad(v, pad4)
        g, beta = jnp.pad(g, pad4[:3]), jnp.pad(beta, pad4[:3])
    to_c = lambda t: t.reshape(B, n, C, H, t.shape[-1]).transpose(1, 0, 3, 2, 4)
    q, k, v = to_c(q), to_c(k), to_c(v)
    g = g.reshape(B, n, C, H).transpose(1, 0, 3, 2)
    beta = beta.reshape(B, n, C, H).transpose(1, 0, 3, 2)
    gc = jnp.cumsum(g, axis=-1)
    incl = jnp.tril(jnp.ones((C, C), dtype=bool))
    strict = jnp.tril(jnp.ones((C, C), dtype=bool), -1)
    diff = gc[..., :, None] - gc[..., None, :]
    decay = jnp.where(incl, jnp.exp(jnp.where(incl, diff, 0.0)), 0.0)
    kb = k * beta[..., None]
    a = jnp.where(strict, jnp.einsum('nbhid,nbhjd->nbhij', kb, k) * decay, 0.0)
    m = a + jnp.eye(C, dtype=a.dtype)
    rhs = jnp.concatenate([v * beta[..., None], kb * jnp.exp(gc)[..., None]], axis=-1)
    sol = lax.linalg.triangular_solve(m, rhs, left_side=True, lower=True, unit_diagonal=True)
    u, w = sol[..., :DV], sol[..., DV:]
    qk = jnp.einsum('nbhid,nbhjd->nbhij', q, k) * decay
    q_dec = q * jnp.exp(gc)[..., None]
    k_dec = k * jnp.exp(gc[..., -1:] - gc)[..., None]
    g_last = jnp.exp(gc[..., -1])

    def step(s, xs):
        qk_i, qd_i, kd_i, u_i, w_i, gl_i = xs
        v_new = u_i - jnp.einsum('bhck,bhkv->bhcv', w_i, s)
        o_i = jnp.einsum('bhck,bhkv->bhcv', qd_i, s) + jnp.einsum('bhij,bhjv->bhiv', qk_i, v_new)
        s = s * gl_i[..., None, None] + jnp.einsum('bhck,bhcv->bhkv', kd_i, v_new)
        return s, o_i

    s_fin, o = lax.scan(step, s0, (qk, q_dec, k_dec, u, w, g_last))
    o = o.transpose(1, 0, 3, 2, 4).reshape(B, n * C, H, DV)[:, :L]
    return o, s_fin


def fox_attention(q, k, v, fq, fk, q_pos, k_pos):
    B, Lq, H, D = q.shape
    qb = min(Q_BLOCK, Lq)
    nb = -(-Lq // qb)
    pad = nb * qb - Lq
    if pad:
        q = jnp.pad(q, ((0, 0), (0, pad), (0, 0), (0, 0)))
        fq = jnp.pad(fq, ((0, 0), (0, pad), (0, 0)))
        q_pos = jnp.pad(q_pos, (0, pad), mode='edge')
    qs = q.reshape(B, nb, qb, H, D).swapaxes(0, 1)
    fqs = fq.reshape(B, nb, qb, H).transpose(1, 0, 3, 2)
    ps = q_pos.reshape(nb, qb)
    fk_t = fk.transpose(0, 2, 1)
    scale = D ** -0.5

    def block(xs):
        q_i, fq_i, p_i = xs
        s = jnp.einsum('bqhd,bkhd->bhqk', q_i, k, preferred_element_type=jnp.float32) * scale
        s = s + (fq_i[..., :, None] - fk_t[..., None, :])
        s = jnp.where(k_pos[None, None, None, :] <= p_i[None, None, :, None], s, -jnp.inf)
        p = jax.nn.softmax(s, axis=-1)
        return jnp.einsum('bhqk,bkhd->bqhd', p.astype(v.dtype), v)

    o = lax.map(block, (qs, fqs, ps))
    return o.swapaxes(0, 1).reshape(B, nb * qb, H, D)[:, :Lq]


def mixer_layer(x, conv_buf, ssm0, past, w_in, conv_w, a_log, dt_bias, onorm_w, f_bias, w_out, norm_w):
    B, L, _ = x.shape
    f32 = jnp.float32
    h = rms_norm(x, norm_w)
    proj = h @ w_in
    qkv_g, z_g, b_g, a_g, q_f, k_f, v_f, z_f, f_f = split_proj(proj)

    qkv_c, new_conv = short_conv(qkv_g, conv_buf, conv_w)
    q_g, k_g, v_g = jnp.split(qkv_c, [GDN_KEY_W, 2 * GDN_KEY_W], axis=-1)
    q_g = l2_normalize(q_g.reshape(B, L, GDN_HEADS, GDN_DK).astype(f32)) * (GDN_DK ** -0.5)
    k_g = l2_normalize(k_g.reshape(B, L, GDN_HEADS, GDN_DK).astype(f32))
    v_g = v_g.reshape(B, L, GDN_HEADS, GDN_DV).astype(f32)
    beta = jax.nn.sigmoid(b_g.astype(f32))
    g = -jnp.exp(a_log.astype(f32)) * jax.nn.softplus(a_g.astype(f32) + dt_bias.astype(f32))
    o_g, ssm_new = gdn_chunked(q_g, k_g, v_g, g, beta, ssm0.astype(f32))
    o_g = rms_norm(o_g, onorm_w).reshape(B, L, GDN_WIDTH) * jax.nn.silu(z_g.astype(f32))

    q_f = q_f.reshape(B, L, FOX_HEADS, HEAD_DIM)
    k_f = k_f.reshape(B, L, FOX_HEADS, HEAD_DIM)
    v_f = v_f.reshape(B, L, FOX_HEADS, HEAD_DIM)
    logf = jax.nn.log_sigmoid((f_f + f_bias).astype(f32))
    if past is None:
        fq = jnp.cumsum(logf, axis=1)
        fk, keys, vals = fq, k_f, v_f
        q_pos = jnp.arange(L)
        k_pos = q_pos
    else:
        pk, pv, plogf = past
        P = pk.shape[1]
        f_past = jnp.cumsum(plogf.astype(f32), axis=1)
        fq = f_past[:, -1:] + jnp.cumsum(logf, axis=1)
        fk = jnp.concatenate([f_past, fq], axis=1)
        keys = jnp.concatenate([pk.astype(k_f.dtype), k_f], axis=1)
        vals = jnp.concatenate([pv.astype(v_f.dtype), v_f], axis=1)
        q_pos = P + jnp.arange(L)
        k_pos = jnp.arange(P + L)
    o_f = fox_attention(q_f, keys, vals, fq, fk, q_pos, k_pos)
    o_f = o_f.reshape(B, L, FOX_WIDTH).astype(f32) * jax.nn.silu(z_f.astype(f32))

    o = jnp.concatenate([o_g, o_f], axis=-1).astype(x.dtype) @ w_out
    y = x + o
    return y, new_conv, ssm_new.astype(x.dtype), k_f, v_f, logf.astype(x.dtype)


def setup_inputs(seed: int = 0) -> dict:
    key = jax.random.key(seed)
    ks = jax.random.split(key, 20)
    nrm = jax.random.normal
    n_pages = PAST_LEN // PAGE_SIZE
    n_used = DEC_BATCH * n_pages
    n_pool = (5 * n_used + 3) // 4
    x_prompt = nrm(ks[0], (BATCH, SEQ, D_MODEL), jnp.float32)
    x_sample = nrm(ks[1], (DEC_BATCH, DEC_SEQ, D_MODEL), jnp.float32)
    cache_fox_k = nrm(ks[2], (DEPTH, n_pool, PAGE_SIZE, FOX_HEADS, HEAD_DIM), jnp.float32)
    cache_fox_v = nrm(ks[3], (DEPTH, n_pool, PAGE_SIZE, FOX_HEADS, HEAD_DIM), jnp.float32)
    cache_fox_logf = jax.nn.log_sigmoid(FGATE_BIAS_MEAN + nrm(ks[4], (DEPTH, n_pool, PAGE_SIZE, FOX_HEADS), jnp.float32))
    page_table = jax.random.permutation(ks[5], n_pool)[:n_used].reshape(DEC_BATCH, n_pages).astype(jnp.int32)
    state_gdn_ssm = 0.1 * nrm(ks[6], (DEPTH, DEC_BATCH, GDN_HEADS, GDN_DK, GDN_DV), jnp.float32)
    state_gdn_conv = nrm(ks[7], (DEPTH, DEC_BATCH, CONV_K - 1, GDN_CONV_DIM), jnp.float32)
    w_in = nrm(ks[8], (DEPTH, D_MODEL, D_IN), jnp.float32) * D_MODEL ** -0.5
    gdn_conv_w = nrm(ks[9], (DEPTH, CONV_K, GDN_CONV_DIM), jnp.float32) * CONV_K ** -0.5
    gdn_a_log = jnp.log(jax.random.uniform(ks[10], (DEPTH, GDN_HEADS), jnp.float32, 1.0, 16.0))
    dt = jnp.exp(jax.random.uniform(ks[11], (DEPTH, GDN_HEADS), jnp.float32, math.log(1e-3), math.log(1e-1)))
    gdn_dt_bias = dt + jnp.log(-jnp.expm1(-dt))
    gdn_out_norm_w = 1.0 + 0.02 * nrm(ks[12], (DEPTH, GDN_DV), jnp.float32)
    fox_f_bias = FGATE_BIAS_MEAN + 0.5 * nrm(ks[13], (DEPTH, FOX_HEADS), jnp.float32)
    w_out = nrm(ks[14], (DEPTH, D_MIX, D_MODEL), jnp.float32) * D_MIX ** -0.5
    norm_w = 1.0 + 0.02 * nrm(ks[15], (DEPTH, D_MODEL), jnp.float32)
    final_norm_w = 1.0 + 0.02 * nrm(ks[16], (D_MODEL,), jnp.float32)
    return {'x_prompt': x_prompt, 'x_sample': x_sample,
            'cache_fox_k': cache_fox_k, 'cache_fox_v': cache_fox_v, 'cache_fox_logf': cache_fox_logf,
            'page_table': page_table, 'state_gdn_ssm': state_gdn_ssm, 'state_gdn_conv': state_gdn_conv,
            'w_in': w_in, 'gdn_conv_w': gdn_conv_w, 'gdn_a_log': gdn_a_log, 'gdn_dt_bias': gdn_dt_bias,
            'gdn_out_norm_w': gdn_out_norm_w, 'fox_f_bias': fox_f_bias, 'w_out': w_out,
            'norm_w': norm_w, 'final_norm_w': final_norm_w}


def reference(x_prompt, x_sample, cache_fox_k, cache_fox_v, cache_fox_logf, page_table,
              state_gdn_ssm, state_gdn_conv, w_in, gdn_conv_w, gdn_a_log, gdn_dt_bias,
              gdn_out_norm_w, fox_f_bias, w_out, norm_w, final_norm_w):
    hp, hs = x_prompt, x_sample
    bp = x_prompt.shape[0]
    bs, n_pages = page_table.shape
    pro, sam = [], []
    for l in range(DEPTH):
        lw = (w_in[l], gdn_conv_w[l], gdn_a_log[l], gdn_dt_bias[l], gdn_out_norm_w[l],
              fox_f_bias[l], w_out[l], norm_w[l])
        conv0 = jnp.zeros((bp, CONV_K - 1, GDN_CONV_DIM), hp.dtype)
        ssm0 = jnp.zeros((bp, GDN_HEADS, GDN_DK, GDN_DV), jnp.float32)
        out_p = mixer_layer(hp, conv0, ssm0, None, *lw)
        hp = out_p[0]
        pro.append(out_p[1:])
        past = tuple(c[l][page_table].reshape(bs, n_pages * PAGE_SIZE, *c.shape[3:])
                     for c in (cache_fox_k, cache_fox_v, cache_fox_logf))
        out_s = mixer_layer(hs, state_gdn_conv[l], state_gdn_ssm[l], past, *lw)
        hs = out_s[0]
        sam.append(out_s[1:])
    y_prompt = rms_norm(hp, final_norm_w)
    y_sample = rms_norm(hs, final_norm_w)
    conv_prompt = jnp.stack([r[0] for r in pro])
    ssm_prompt = jnp.stack([r[1] for r in pro])
    k_prompt = jnp.stack([r[2] for r in pro])
    v_prompt = jnp.stack([r[3] for r in pro])
    logf_prompt = jnp.stack([r[4] for r in pro])
    conv_sample = jnp.stack([r[0] for r in sam])
    ssm_sample = jnp.stack([r[1] for r in sam])
    k_sample = jnp.stack([r[2] for r in sam])
    v_sample = jnp.stack([r[3] for r in sam])
    logf_sample = jnp.stack([r[4] for r in sam])
    return (y_prompt, y_sample, k_prompt, v_prompt, logf_prompt, ssm_prompt, conv_prompt,
            k_sample, v_sample, logf_sample, ssm_sample, conv_sample)
```

```cpp
#include <hip/hip_runtime.h>
#include <stdint.h>

namespace {
constexpr int D_MODEL = 1024, BATCH = 8, SEQ = 2048, DEC_BATCH = 128, DEC_SEQ = 4, PAST = 2048, PAGE = 128, NPAGES = 16;
constexpr int HD = 128, NH = 4;
constexpr int CONV_DIM = 1536, D_IN = 4108;
constexpr int MP = BATCH * SEQ, MS = DEC_BATCH * DEC_SEQ, MT = MP + MS;
constexpr int C_QKVG = 0, C_ZG = 1536, C_BG = 2048, C_AG = 2052, C_QF = 2056, C_KF = 2568, C_VF = 3080, C_ZF = 3592, C_FF = 4104;
constexpr size_t O_YP = 0, O_YS = O_YP + (size_t)MP * 1024, O_KP = O_YS + (size_t)MS * 1024, O_VP = O_KP + (size_t)MP * 512,
                 O_LP = O_VP + (size_t)MP * 512, O_SSMP = O_LP + (size_t)MP * 4, O_CONVP = O_SSMP + (size_t)BATCH * 4 * 128 * 128,
                 O_KS = O_CONVP + (size_t)BATCH * 3 * 1536, O_VS = O_KS + (size_t)MS * 512, O_LS = O_VS + (size_t)MS * 512,
                 O_SSMS = O_LS + (size_t)MS * 4, O_CONVS = O_SSMS + (size_t)DEC_BATCH * 4 * 128 * 128, O_END = O_CONVS + (size_t)DEC_BATCH * 3 * 1536;
constexpr size_t MiB = 1u << 20;
constexpr size_t W_H = 16 * MiB;
constexpr size_t W_PROJ = W_H + 72 * MiB;
constexpr size_t W_QKVC = W_PROJ + 272 * MiB;
constexpr size_t W_BETA = W_QKVC + 104 * MiB;
constexpr size_t W_G = W_BETA + 1 * MiB;
constexpr size_t W_LOGF = W_G + 1 * MiB;
constexpr size_t W_F = W_LOGF + 1 * MiB;
constexpr size_t W_FP = W_F + 1 * MiB;
constexpr size_t W_OG = W_FP + 8 * MiB;
constexpr size_t W_OMIX = W_OG + 40 * MiB;
constexpr size_t W_YPRE = W_OMIX + 72 * MiB;
constexpr size_t W_END = W_YPRE + 72 * MiB;

__device__ __forceinline__ float sigmoidf_(float x) { return 1.f / (1.f + expf(-x)); }
__device__ __forceinline__ float siluf_(float x) { return x / (1.f + expf(-x)); }
__device__ __forceinline__ float softplusf_(float x) { return fmaxf(x, 0.f) + log1pf(expf(-fabsf(x))); }
__device__ __forceinline__ float logsigmoidf_(float x) { return -softplusf_(-x); }

__device__ __forceinline__ const float* xrow(const float* xp, const float* xs, int row) {
    return row < MP ? xp + (size_t)row * D_MODEL : xs + (size_t)(row - MP) * D_MODEL;
}

__global__ __launch_bounds__(256) void k_rmsnorm(const float* xp, const float* xs, const float* w, float* H) {
    __shared__ float red[4];
    const int row = blockIdx.x, t = threadIdx.x;
    const float* x = xrow(xp, xs, row);
    float4 v = ((const float4*)x)[t];
    float ss = v.x * v.x + v.y * v.y + v.z * v.z + v.w * v.w;
    for (int o = 32; o >= 1; o >>= 1) ss += __shfl_xor(ss, o);
    if ((t & 63) == 0) red[t >> 6] = ss;
    __syncthreads();
    const float tot = red[0] + red[1] + red[2] + red[3];
    const float r = rsqrtf(tot * (1.f / D_MODEL) + 1e-6f);
    float4 wv = ((const float4*)w)[t];
    float4 o4 = make_float4(v.x * r * wv.x, v.y * r * wv.y, v.z * r * wv.z, v.w * r * wv.w);
    ((float4*)(H + (size_t)row * D_MODEL))[t] = o4;
}

__global__ __launch_bounds__(256) void k_sgemm(const float* A, const float* B, float* C, int M, int N, int K, const float* xp, const float* xs) {
    __shared__ float As[16][68];
    __shared__ float Bs[16][68];
    const int tx = threadIdx.x & 15, ty = threadIdx.x >> 4;
    const int m0 = blockIdx.y * 64, n0 = blockIdx.x * 64;
    float acc[4][4];
#pragma unroll
    for (int i = 0; i < 4; ++i)
#pragma unroll
        for (int j = 0; j < 4; ++j) acc[i][j] = 0.f;
    for (int k0 = 0; k0 < K; k0 += 16) {
        for (int i = threadIdx.x; i < 1024; i += 256) { const int r = i >> 4, kk = i & 15; As[kk][r] = A[(size_t)(m0 + r) * K + k0 + kk]; }
        for (int i = threadIdx.x; i < 1024; i += 256) { const int kk = i >> 6, c = i & 63; const int n = n0 + c; Bs[kk][c] = n < N ? B[(size_t)(k0 + kk) * N + n] : 0.f; }
        __syncthreads();
#pragma unroll
        for (int kk = 0; kk < 16; ++kk) {
            float a[4], b[4];
#pragma unroll
            for (int i = 0; i < 4; ++i) { a[i] = As[kk][ty * 4 + i]; b[i] = Bs[kk][tx * 4 + i]; }
#pragma unroll
            for (int i = 0; i < 4; ++i)
#pragma unroll
                for (int j = 0; j < 4; ++j) acc[i][j] = fmaf(a[i], b[j], acc[i][j]);
        }
        __syncthreads();
    }
#pragma unroll
    for (int i = 0; i < 4; ++i) {
        const int row = m0 + ty * 4 + i;
#pragma unroll
        for (int j = 0; j < 4; ++j) {
            const int col = n0 + tx * 4 + j;
            if (col < N) {
                float v = acc[i][j];
                if (xp) v += xrow(xp, xs, row)[col];
                C[(size_t)row * N + col] = v;
            }
        }
    }
}

__global__ __launch_bounds__(256) void k_post_proj(const float* PROJ, const float* a_log, const float* dt_bias, const float* f_bias,
                                                   float* out, float* BETA, float* G, float* LOGF) {
    const int row = blockIdx.x, t = threadIdx.x;
    const float* p = PROJ + (size_t)row * D_IN;
    float* ko = row < MP ? out + O_KP + (size_t)row * 512 : out + O_KS + (size_t)(row - MP) * 512;
    float* vo = row < MP ? out + O_VP + (size_t)row * 512 : out + O_VS + (size_t)(row - MP) * 512;
    for (int c = t; c < 512; c += 256) { ko[c] = p[C_KF + c]; vo[c] = p[C_VF + c]; }
    if (t < 4) {
        const float lf = logsigmoidf_(p[C_FF + t] + f_bias[t]);
        LOGF[row * 4 + t] = lf;
        if (row < MP) out[O_LP + (size_t)row * 4 + t] = lf; else out[O_LS + (size_t)(row - MP) * 4 + t] = lf;
        BETA[row * 4 + t] = sigmoidf_(p[C_BG + t]);
        G[row * 4 + t] = -expf(a_log[t]) * softplusf_(p[C_AG + t] + dt_bias[t]);
    }
    int j = -1; float* co = nullptr;
    if (row < MP) { const int b = row / SEQ, tt = row % SEQ; if (tt >= SEQ - 3) { j = tt - (SEQ - 3); co = out + O_CONVP + ((size_t)b * 3 + j) * CONV_DIM; } }
    else { const int r = row - MP, b = r / DEC_SEQ, tt = r % DEC_SEQ; if (tt >= 1) { j = tt - 1; co = out + O_CONVS + ((size_t)b * 3 + j) * CONV_DIM; } }
    if (j >= 0) for (int c = t; c < CONV_DIM; c += 256) co[c] = p[c];
}

__global__ __launch_bounds__(256) void k_conv(const float* PROJ, const float* conv_w, const float* state_conv, float* QKVC) {
    const int row = blockIdx.x;
    int b, tt; bool samp = row >= MP;
    if (!samp) { b = row / SEQ; tt = row % SEQ; } else { b = (row - MP) / DEC_SEQ; tt = (row - MP) % DEC_SEQ; }
    for (int c = threadIdx.x; c < CONV_DIM; c += 256) {
        float y = 0.f;
#pragma unroll
        for (int j = 0; j < 4; ++j) {
            const int ts = tt - 3 + j; float xv;
            if (ts >= 0) xv = PROJ[(size_t)(row - tt + ts) * D_IN + c];
            else xv = samp ? state_conv[((size_t)b * 3 + (3 + ts)) * CONV_DIM + c] : 0.f;
            y = fmaf(conv_w[j * CONV_DIM + c], xv, y);
        }
        QKVC[(size_t)row * CONV_DIM + c] = siluf_(y);
    }
}

__global__ __launch_bounds__(256) void k_gdn_rec(const float* QKVC, const float* BETA, const float* G, const float* state_ssm, float* OG, float* out) {
    __shared__ float sq[128], sk[128], sv[128], sp[2][128];
    __shared__ float sn[2];
    const int h = blockIdx.x & 3, sidx = blockIdx.x >> 2;
    const bool samp = sidx >= BATCH; const int b = samp ? sidx - BATCH : sidx;
    const int L = samp ? DEC_SEQ : SEQ; const int row0 = samp ? MP + b * DEC_SEQ : b * SEQ;
    const int tid = threadIdx.x, dv = tid & 127, half = tid >> 7;
    float S[64];
    if (samp) { const float* s0 = state_ssm + ((size_t)(b * 4 + h) * 128) * 128;
#pragma unroll
        for (int i = 0; i < 64; ++i) S[i] = s0[(size_t)(64 * half + i) * 128 + dv]; }
    else {
#pragma unroll
        for (int i = 0; i < 64; ++i) S[i] = 0.f; }
    for (int t = 0; t < L; ++t) {
        const int row = row0 + t; const float* qc = QKVC + (size_t)row * CONV_DIM;
        if (half == 0) { sq[dv] = qc[h * 128 + dv]; sv[dv] = qc[1024 + h * 128 + dv]; } else { sk[dv] = qc[512 + h * 128 + dv]; }
        __syncthreads();
        if (tid < 64) { float a = sq[tid] * sq[tid] + sq[tid + 64] * sq[tid + 64]; for (int o = 32; o >= 1; o >>= 1) a += __shfl_xor(a, o); if (tid == 0) sn[0] = rsqrtf(a + 1e-6f) * 0.08838834764831845f; }
        else if (tid < 128) { const int l = tid - 64; float a = sk[l] * sk[l] + sk[l + 64] * sk[l + 64]; for (int o = 32; o >= 1; o >>= 1) a += __shfl_xor(a, o); if (l == 0) sn[1] = rsqrtf(a + 1e-6f); }
        __syncthreads();
        const float qs = sn[0], ks = sn[1], a = expf(G[row * 4 + h]), beta = BETA[row * 4 + h];
        float p = 0.f;
#pragma unroll
        for (int i = 0; i < 64; ++i) { S[i] *= a; p = fmaf(S[i], sk[64 * half + i] * ks, p); }
        sp[half][dv] = p;
        __syncthreads();
        const float r = sv[dv] - (sp[0][dv] + sp[1][dv]);
        __syncthreads();
        float po = 0.f;
#pragma unroll
        for (int i = 0; i < 64; ++i) { S[i] = fmaf(beta * (sk[64 * half + i] * ks), r, S[i]); po = fmaf(S[i], sq[64 * half + i] * qs, po); }
        sp[half][dv] = po;
        __syncthreads();
        if (half == 0) OG[(size_t)row * 512 + h * 128 + dv] = sp[0][dv] + sp[1][dv];
        __syncthreads();
    }
    float* so = samp ? out + O_SSMS + ((size_t)(b * 4 + h) * 128) * 128 : out + O_SSMP + ((size_t)(b * 4 + h) * 128) * 128;
#pragma unroll
    for (int i = 0; i < 64; ++i) so[(size_t)(64 * half + i) * 128 + dv] = S[i];
}

__global__ __launch_bounds__(256) void k_og_final(const float* OG, const float* PROJ, const float* onw, float* OMIX) {
    const int row = blockIdx.x, h = threadIdx.x >> 6, l = threadIdx.x & 63;
    const float* o = OG + (size_t)row * 512 + h * 128;
    const float a = o[l], b2 = o[l + 64];
    float ss = a * a + b2 * b2;
    for (int of = 32; of >= 1; of >>= 1) ss += __shfl_xor(ss, of);
    const float r = rsqrtf(ss * (1.f / 128.f) + 1e-6f);
    const float* z = PROJ + (size_t)row * D_IN + C_ZG + h * 128;
    float* om = OMIX + (size_t)row * 1024 + h * 128;
    om[l] = a * r * onw[l] * siluf_(z[l]);
    om[l + 64] = b2 * r * onw[l + 64] * siluf_(z[l + 64]);
}

__global__ void k_fox_cumsum(const float* LOGF, const float* cache_logf, const int* page_table, float* F, float* FP) {
    const int id = blockIdx.x * blockDim.x + threadIdx.x;
    if (id < BATCH * 4) {
        const int b = id >> 2, h = id & 3; float acc = 0.f;
        for (int t = 0; t < SEQ; ++t) { const int row = b * SEQ + t; acc += LOGF[row * 4 + h]; F[row * 4 + h] = acc; }
    } else if (id < BATCH * 4 + DEC_BATCH * 4) {
        const int i2 = id - BATCH * 4, b = i2 >> 2, h = i2 & 3; float acc = 0.f;
        for (int s = 0; s < PAST; ++s) { const int pg = page_table[b * NPAGES + (s >> 7)]; acc += cache_logf[((size_t)pg * PAGE + (s & 127)) * 4 + h]; FP[((size_t)b * 4 + h) * PAST + s] = acc; }
        for (int t = 0; t < DEC_SEQ; ++t) { const int row = MP + b * DEC_SEQ + t; acc += LOGF[row * 4 + h]; F[row * 4 + h] = acc; }
    }
}

__global__ __launch_bounds__(256) void k_fox_attn(const float* PROJ, const float* out, const float* cache_k, const float* cache_v, const int* page_table,
                                                  const float* F, const float* FP, float* OMIX) {
    __shared__ float sc[4][PAST + DEC_SEQ + 12];
    __shared__ float qs[4][128];
    const int row = blockIdx.x, h = threadIdx.x >> 6, l = threadIdx.x & 63;
    const bool samp = row >= MP;
    int b, tt; if (!samp) { b = row / SEQ; tt = row % SEQ; } else { b = (row - MP) / DEC_SEQ; tt = (row - MP) % DEC_SEQ; }
    const int nk = samp ? PAST + tt + 1 : tt + 1;
    const float* q = PROJ + (size_t)row * D_IN + C_QF + h * 128;
    qs[h][l] = q[l]; qs[h][l + 64] = q[l + 64];
    __syncthreads();
    const float fq = F[row * 4 + h];
    float mx = -INFINITY;
    for (int s = l; s < nk; s += 64) {
        const float* kp; float fk;
        if (!samp) { kp = out + O_KP + (size_t)(b * SEQ + s) * 512 + h * 128; fk = F[(b * SEQ + s) * 4 + h]; }
        else if (s < PAST) { const int pg = page_table[b * NPAGES + (s >> 7)]; kp = cache_k + (((size_t)pg * PAGE + (s & 127)) * 4 + h) * 128; fk = FP[((size_t)b * 4 + h) * PAST + s]; }
        else { const int r2 = MP + b * DEC_SEQ + (s - PAST); kp = out + O_KS + (size_t)(r2 - MP) * 512 + h * 128; fk = F[r2 * 4 + h]; }
        float d = 0.f;
        for (int i = 0; i < 32; ++i) { const float4 kv = ((const float4*)kp)[i]; d = fmaf(kv.x, qs[h][4 * i], d); d = fmaf(kv.y, qs[h][4 * i + 1], d); d = fmaf(kv.z, qs[h][4 * i + 2], d); d = fmaf(kv.w, qs[h][4 * i + 3], d); }
        const float s_ = d * 0.08838834764831845f + (fq - fk);
        sc[h][s] = s_; mx = fmaxf(mx, s_);
    }
    for (int o = 32; o >= 1; o >>= 1) mx = fmaxf(mx, __shfl_xor(mx, o));
    float sum = 0.f;
    for (int s = l; s < nk; s += 64) { const float p = expf(sc[h][s] - mx); sc[h][s] = p; sum += p; }
    for (int o = 32; o >= 1; o >>= 1) sum += __shfl_xor(sum, o);
    __syncthreads();
    float o0 = 0.f, o1 = 0.f;
    for (int s = 0; s < nk; ++s) {
        const float* vp;
        if (!samp) vp = out + O_VP + (size_t)(b * SEQ + s) * 512 + h * 128;
        else if (s < PAST) { const int pg = page_table[b * NPAGES + (s >> 7)]; vp = cache_v + (((size_t)pg * PAGE + (s & 127)) * 4 + h) * 128; }
        else vp = out + O_VS + (size_t)(b * DEC_SEQ + (s - PAST)) * 512 + h * 128;
        const float p = sc[h][s];
        o0 = fmaf(p, vp[l], o0); o1 = fmaf(p, vp[l + 64], o1);
    }
    const float inv = 1.f / sum;
    const float* z = PROJ + (size_t)row * D_IN + C_ZF + h * 128;
    float* om = OMIX + (size_t)row * 1024 + 512 + h * 128;
    om[l] = o0 * inv * siluf_(z[l]); om[l + 64] = o1 * inv * siluf_(z[l + 64]);
}

__global__ __launch_bounds__(256) void k_final_norm(const float* YPRE, const float* w, float* out) {
    __shared__ float red[4];
    const int row = blockIdx.x, t = threadIdx.x;
    float4 v = ((const float4*)(YPRE + (size_t)row * D_MODEL))[t];
    float ss = v.x * v.x + v.y * v.y + v.z * v.z + v.w * v.w;
    for (int o = 32; o >= 1; o >>= 1) ss += __shfl_xor(ss, o);
    if ((t & 63) == 0) red[t >> 6] = ss;
    __syncthreads();
    const float r = rsqrtf((red[0] + red[1] + red[2] + red[3]) * (1.f / D_MODEL) + 1e-6f);
    float4 wv = ((const float4*)w)[t];
    float* o = row < MP ? out + O_YP + (size_t)row * D_MODEL : out + O_YS + (size_t)(row - MP) * D_MODEL;
    ((float4*)o)[t] = make_float4(v.x * r * wv.x, v.y * r * wv.y, v.z * r * wv.z, v.w * r * wv.w);
}
}

extern "C" void kernel_launch(void* const* d_in, const int* in_sizes, int n_in, void* d_out, int out_size, void* d_ws, size_t ws_size, hipStream_t stream) {
    const float* x_prompt = (const float*)d_in[0]; const float* x_sample = (const float*)d_in[1];
    const float* cache_k = (const float*)d_in[2]; const float* cache_v = (const float*)d_in[3]; const float* cache_logf = (const float*)d_in[4];
    const int* page_table = (const int*)d_in[5]; const float* state_ssm = (const float*)d_in[6]; const float* state_conv = (const float*)d_in[7];
    const float* w_in = (const float*)d_in[8]; const float* conv_w = (const float*)d_in[9]; const float* a_log = (const float*)d_in[10];
    const float* dt_bias = (const float*)d_in[11]; const float* onorm_w = (const float*)d_in[12]; const float* f_bias = (const float*)d_in[13];
    const float* w_out = (const float*)d_in[14]; const float* norm_w = (const float*)d_in[15]; const float* final_norm_w = (const float*)d_in[16];
    float* out = (float*)d_out; char* ws = (char*)d_ws;
    if (n_in != 17 || (size_t)out_size != O_END || ws_size < W_END) return;
    float* H = (float*)(ws + W_H); float* PROJ = (float*)(ws + W_PROJ); float* QKVC = (float*)(ws + W_QKVC);
    float* BETA = (float*)(ws + W_BETA); float* G = (float*)(ws + W_G); float* LOGF = (float*)(ws + W_LOGF); float* F = (float*)(ws + W_F);
    float* FP = (float*)(ws + W_FP); float* OG = (float*)(ws + W_OG); float* OMIX = (float*)(ws + W_OMIX); float* YPRE = (float*)(ws + W_YPRE);
    k_rmsnorm<<<MT, 256, 0, stream>>>(x_prompt, x_sample, norm_w, H);
    k_sgemm<<<dim3((D_IN + 63) / 64, MT / 64), 256, 0, stream>>>(H, w_in, PROJ, MT, D_IN, D_MODEL, nullptr, nullptr);
    k_post_proj<<<MT, 256, 0, stream>>>(PROJ, a_log, dt_bias, f_bias, out, BETA, G, LOGF);
    k_conv<<<MT, 256, 0, stream>>>(PROJ, conv_w, state_conv, QKVC);
    k_gdn_rec<<<(BATCH + DEC_BATCH) * 4, 256, 0, stream>>>(QKVC, BETA, G, state_ssm, OG, out);
    k_og_final<<<MT, 256, 0, stream>>>(OG, PROJ, onorm_w, OMIX);
    k_fox_cumsum<<<(BATCH * 4 + DEC_BATCH * 4 + 63) / 64, 64, 0, stream>>>(LOGF, cache_logf, page_table, F, FP);
    k_fox_attn<<<MT, 256, 0, stream>>>(PROJ, out, cache_k, cache_v, page_table, F, FP, OMIX);
    k_sgemm<<<dim3(D_MODEL / 64, MT / 64), 256, 0, stream>>>(OMIX, w_out, YPRE, MT, D_MODEL, D_MODEL, x_prompt, x_sample);
    k_final_norm<<<MT, 256, 0, stream>>>(YPRE, final_norm_w, out);
}
```

```cpp
#include <hip/hip_runtime.h>
#include <stdint.h>
#include <cstdio>

constexpr int D_MODEL = 1024, BATCH = 8, SEQ = 2048, DEC_BATCH = 128, DEC_SEQ = 4, PAST = 2048, PAGE = 128, NPAGES = 16;
constexpr int HD = 128, NH = 4;
constexpr int CONV_DIM = 1536, D_IN = 4108;
constexpr int MP = BATCH * SEQ, MS = DEC_BATCH * DEC_SEQ, MT = MP + MS;
constexpr int C_QKVG = 0, C_ZG = 1536, C_BG = 2048, C_AG = 2052, C_QF = 2056, C_KF = 2568, C_VF = 3080, C_ZF = 3592, C_FF = 4104;
constexpr size_t O_YP = 0, O_YS = O_YP + (size_t)MP * 1024, O_KP = O_YS + (size_t)MS * 1024, O_VP = O_KP + (size_t)MP * 512,
                 O_LP = O_VP + (size_t)MP * 512, O_SSMP = O_LP + (size_t)MP * 4, O_CONVP = O_SSMP + (size_t)BATCH * 4 * 128 * 128,
                 O_KS = O_CONVP + (size_t)BATCH * 3 * 1536, O_VS = O_KS + (size_t)MS * 512, O_LS = O_VS + (size_t)MS * 512,
                 O_SSMS = O_LS + (size_t)MS * 4, O_CONVS = O_SSMS + (size_t)DEC_BATCH * 4 * 128 * 128, O_END = O_CONVS + (size_t)DEC_BATCH * 3 * 1536;
constexpr size_t MiB = 1u << 20;
constexpr size_t W_CTL = 0, CTL_BYTES = 1 * MiB;
constexpr size_t W_WINT = 2 * MiB;
constexpr size_t W_WSM = W_WINT + 8 * MiB;
constexpr size_t W_WOUT = W_WSM + 1 * MiB;
constexpr size_t W_HB = W_WOUT + 2 * MiB;
constexpr size_t W_QKVG = W_HB + 34 * MiB;
constexpr size_t W_ZG = W_QKVG + 50 * MiB;
constexpr size_t W_ZF = W_ZG + 17 * MiB;
constexpr size_t W_QFP = W_ZF + 17 * MiB;
constexpr size_t W_KFP = W_QFP + 16 * MiB;
constexpr size_t W_VFP = W_KFP + 16 * MiB;
constexpr size_t W_QFS = W_VFP + 16 * MiB;
constexpr size_t W_BETA = W_QFS + 1 * MiB;
constexpr size_t W_G = W_BETA + 1 * MiB;
constexpr size_t W_LOGF = W_G + 1 * MiB;
constexpr size_t W_F = W_LOGF + 1 * MiB;
constexpr size_t W_FP = W_F + 1 * MiB;
constexpr size_t W_OMIX = W_FP + 4 * MiB;
constexpr size_t W_YPRE = W_OMIX + 34 * MiB;
constexpr size_t W_PART = W_YPRE + 67 * MiB;
constexpr size_t W_OG = W_PART + 2 * MiB;
constexpr size_t W_QKVC = W_OG + 34 * MiB;
constexpr size_t W_END = W_QKVC + 100 * MiB;

#define LAS __attribute__((address_space(3)))
typedef unsigned short bf16_t;
__device__ __forceinline__ float sigmoidf_(float x) { return 1.f / (1.f + expf(-x)); }
__device__ __forceinline__ float siluf_(float x) { return x / (1.f + expf(-x)); }
__device__ __forceinline__ float softplusf_(float x) { return fmaxf(x, 0.f) + log1pf(expf(-fabsf(x))); }
__device__ __forceinline__ float logsigmoidf_(float x) { return -softplusf_(-x); }
__device__ __forceinline__ float bf2f(bf16_t b) { return __uint_as_float(((unsigned)b) << 16); }
__device__ __forceinline__ unsigned f2bf(float f) { unsigned u = __float_as_uint(f); return (u + 0x7fffu + ((u >> 16) & 1u)) >> 16; }
__device__ __forceinline__ unsigned pk2(float lo, float hi) { return f2bf(lo) | (f2bf(hi) << 16); }
__device__ __forceinline__ const float* xrow(const float* xp, const float* xs, int row) {
    return row < MP ? xp + (size_t)row * D_MODEL : xs + (size_t)(row - MP) * D_MODEL;
}

namespace pg8 {
#define PG8_LAS __attribute__((address_space(3)))
typedef unsigned short bf16_t;
typedef short bf16x8 __attribute__((ext_vector_type(8)));
typedef float f32x4 __attribute__((ext_vector_type(4)));
typedef unsigned u32x4 __attribute__((ext_vector_type(4)));
constexpr int BM = 256, BK = 64, HALF = 128, HTB = HALF * BK * 2  , STAGE_BYTES = 8 * HTB, NXCD = 8, WGM = 8;

__host__ __device__ __forceinline__ int lds_byte(int r, int c) { const int st = (r >> 4) * 2 + (c >> 5), rr = r & 15, cc = c & 31, ob = rr * 64 + cc * 2; return st * 1024 + (ob ^ (((ob >> 9) & 1) << 5)); }
__host__ __device__ __forceinline__ void stage_rc(int b, int& R, int& C) { const int st = b / 1024, sb = b % 1024, swz = sb ^ (((sb >> 9) & 1) << 5); R = (st >> 1) * 16 + swz / 64; C = (st & 1) * 32 + (swz % 64) / 2; }
__host__ __device__ __forceinline__ int perm32(int rho) { const int n = rho >> 4, i = rho & 15; return 8 * (i >> 2) + 4 * n + (i & 3); }

struct Unit { int pm, pn; };
struct Gemm { const bf16_t* A; const bf16_t* Bt; int M, N, K; };

struct StaticOrder {
    int nM, nN, nwg, G, c;
    __host__ __device__ void init(int M, int N, int G_, int c_) { nM = M / BM; nN = N / BM; nwg = nM * nN; G = G_; c = c_; }
    __host__ __device__ bool next(int i, Unit& u) const {
        const long L = (long)i * G + c; if (L >= nwg) return false;
        int wgid = (int)L; { const int q = nwg / NXCD, r = nwg % NXCD, xcd = wgid % NXCD, off = wgid / NXCD; wgid = (xcd < r ? xcd * (q + 1) : r * (q + 1) + (xcd - r) * q) + off; }
        const int nig = WGM * nN, gid = wgid / nig, fm = gid * WGM, gsz = (nM - fm) < WGM ? (nM - fm) : WGM;
        u.pm = fm + ((wgid % nig) % gsz); u.pn = (wgid % nig) / gsz; return true;
    }
    __device__ __forceinline__ void a_ready(const Unit&) const {}
    __device__ __forceinline__ void done(const Unit&) const {}
};

__device__ __forceinline__ unsigned cvt_pk_bf16(float lo, float hi) { unsigned r; asm volatile("v_cvt_pk_bf16_f32 %0, %1, %2" : "=v"(r) : "v"(lo), "v"(hi)); return r; }
__device__ __forceinline__ u32x4 pack8(const f32x4 v0, const f32x4 v1) { u32x4 w; w.x = cvt_pk_bf16(v0[0], v0[1]); w.y = cvt_pk_bf16(v0[2], v0[3]); w.z = cvt_pk_bf16(v1[0], v1[1]); w.w = cvt_pk_bf16(v1[2], v1[3]); return w; }

struct EpiProj {
    static constexpr bool PERM = true, AFTER_DRAIN = false;
    bf16_t* QKVG; bf16_t* ZG; bf16_t* ZF; bf16_t* QFP; bf16_t* KFP; bf16_t* VFP; bf16_t* QFS; float* out;
    __device__ __forceinline__ void operator()(const f32x4 (&acc)[2][2][4][2], const Unit& u, int wr, int wc, int fr, int fq) const {
        const int pn = u.pn; const bool samp = u.pm >= (MP / 256);
        const int rbase = u.pm * BM + wr * 64 + fr, cb = wc * 32 + 8 * fq;
        if (pn < 6) {
            const int c0 = pn * BM + cb;
#pragma unroll
            for (int ai = 0; ai < 2; ++ai)
#pragma unroll
                for (int m = 0; m < 4; ++m) {
                    const int row = rbase + ai * HALF + m * 16;
                    bf16_t* p = QKVG + (size_t)row * CONV_DIM + c0;
                    *(u32x4*)p = pack8(acc[ai][0][m][0], acc[ai][0][m][1]); *(u32x4*)(p + HALF) = pack8(acc[ai][1][m][0], acc[ai][1][m][1]);
                    int j = -1; size_t cob = 0;
                    if (!samp) { const int t = row & 2047; if (t >= SEQ - 3) { j = t - (SEQ - 3); cob = O_CONVP + (size_t)(row >> 11) * 3 * CONV_DIM; } }
                    else { const int r = row - MP, t = r & 3; if (t >= 1) { j = t - 1; cob = O_CONVS + (size_t)(r >> 2) * 3 * CONV_DIM; } }
                    if (j >= 0) { float* co = out + cob + (size_t)j * CONV_DIM + c0;
                        *(f32x4*)co = acc[ai][0][m][0]; *(f32x4*)(co + 4) = acc[ai][0][m][1]; *(f32x4*)(co + HALF) = acc[ai][1][m][0]; *(f32x4*)(co + HALF + 4) = acc[ai][1][m][1]; }
                    asm volatile("" ::: "memory");
                }
        } else if (pn < 8 || pn >= 14) {
            bf16_t* Z = ZG + (pn < 8 ? (size_t)0 : (size_t)((W_ZF - W_ZG) / 2)); const int c0 = (pn < 8 ? pn - 6 : pn - 14) * BM + cb;
#pragma unroll
            for (int ai = 0; ai < 2; ++ai)
#pragma unroll
                for (int m = 0; m < 4; ++m) {
                    const int row = rbase + ai * HALF + m * 16;
                    bf16_t* p = Z + (size_t)row * 512 + c0;
                    *(u32x4*)p = pack8(acc[ai][0][m][0], acc[ai][0][m][1]); *(u32x4*)(p + HALF) = pack8(acc[ai][1][m][0], acc[ai][1][m][1]);
                    asm volatile("" ::: "memory");
                }
        } else {
            const int kind = (pn - 8) >> 1, head0 = ((pn - 8) & 1) * 2;
            bf16_t* HP = QFP + (size_t)kind * ((W_KFP - W_QFP) / 2);
            const size_t ob = kind == 1 ? (samp ? O_KS : O_KP) : (samp ? O_VS : O_VP);
#pragma unroll
            for (int ai = 0; ai < 2; ++ai)
#pragma unroll
                for (int m = 0; m < 4; ++m) {
                    const int row = rbase + ai * HALF + m * 16;
                    if (kind != 0) { float* o = out + ob + (size_t)(samp ? row - MP : row) * 512 + head0 * HD + cb;
                        *(f32x4*)o = acc[ai][0][m][0]; *(f32x4*)(o + 4) = acc[ai][0][m][1]; *(f32x4*)(o + HALF) = acc[ai][1][m][0]; *(f32x4*)(o + HALF + 4) = acc[ai][1][m][1]; }
                    if (!samp) { const int b = row >> 11, t = row & 2047;
                        bf16_t* p = HP + ((size_t)(b * 4 + head0) * SEQ + t) * HD + cb;
                        *(u32x4*)p = pack8(acc[ai][0][m][0], acc[ai][0][m][1]); *(u32x4*)(p + (size_t)SEQ * HD) = pack8(acc[ai][1][m][0], acc[ai][1][m][1]); }
                    else if (kind == 0) { const int r = row - MP, b = r >> 2, t = r & 3;
                        bf16_t* p = QFS + ((size_t)(b * 4 + head0) * DEC_SEQ + t) * HD + cb;
                        *(u32x4*)p = pack8(acc[ai][0][m][0], acc[ai][0][m][1]); *(u32x4*)(p + DEC_SEQ * HD) = pack8(acc[ai][1][m][0], acc[ai][1][m][1]); }
                    asm volatile("" ::: "memory");
                }
        }
    }
};
struct EpiOut {
    static constexpr bool PERM = true, AFTER_DRAIN = false;
    const float* xp; const float* xs; float* YPRE; float* PART;
    __device__ __forceinline__ void operator()(const f32x4 (&acc)[2][2][4][2], const Unit& u, int wr, int wc, int fr, int fq) const {
#pragma unroll
        for (int ai = 0; ai < 2; ++ai)
#pragma unroll
            for (int m = 0; m < 4; ++m) {
                const int row = u.pm * BM + ai * HALF + wr * 64 + m * 16 + fr;
                const float* xr = xrow(xp, xs, row); float ss = 0.f;
#pragma unroll
                for (int bj = 0; bj < 2; ++bj) {
                    const int c0 = u.pn * BM + bj * HALF + wc * 32 + 8 * fq;
                    const f32x4 y0 = acc[ai][bj][m][0] + *(const f32x4*)(xr + c0), y1 = acc[ai][bj][m][1] + *(const f32x4*)(xr + c0 + 4);
                    *(f32x4*)(YPRE + (size_t)row * D_MODEL + c0) = y0; *(f32x4*)(YPRE + (size_t)row * D_MODEL + c0 + 4) = y1;
                    ss += (y0[0] * y0[0] + y0[1] * y0[1]) + (y0[2] * y0[2] + y0[3] * y0[3]) + (y1[0] * y1[0] + y1[1] * y1[1]) + (y1[2] * y1[2] + y1[3] * y1[3]);
                }
                ss += __shfl_xor(ss, 16); ss += __shfl_xor(ss, 32);
                if (fq == 0) PART[(size_t)row * 16 + u.pn * 4 + wc] = ss;
            }
    }
};

template <class Epi, class Sched, bool STAMP = false>
__device__ __forceinline__ void gemm_phase(PG8_LAS unsigned char* lds, const Gemm g, const Sched& S, const Epi& E, unsigned long long* stamps) {
    const int tid = threadIdx.x, wid = __builtin_amdgcn_readfirstlane(tid >> 6), lane = tid & 63, wr = wid >> 2, wc = wid & 3, fr = lane & 15, fq = lane >> 4;
    const int K = g.K, nt = K / BK;
    int ts_lo = 0, ts_hi = 0, nts = 0; const unsigned long long rt_entry = STAMP ? (unsigned long long)wall_clock64() : 0ull;
#define PG8_STAMP() do { if (STAMP && wid == 0 && nts < 64) { const unsigned long long _c = (unsigned long long)clock64(); \
        ts_lo = (lane == nts) ? (int)(unsigned)_c : ts_lo; ts_hi = (lane == nts) ? (int)(unsigned)(_c >> 32) : ts_hi; ++nts; } } while (0)
    PG8_STAMP();
    unsigned voffA[2], voffB[2];
#pragma unroll
    for (int i = 0; i < 2; ++i) { int R, C; stage_rc(tid * 16 + i * 8192, R, C); const int Rb = Epi::PERM ? ((R & ~31) + perm32(R & 31)) : R;
        voffA[i] = (unsigned)(R * K + C) * 2u; voffB[i] = (unsigned)(Rb * K + C) * 2u; }
    const size_t kstep = (size_t)(BK * 2);
    const size_t hstep = (size_t)HALF * K * 2;
    const size_t tstep = 2 * hstep;
    const unsigned ldsw = (unsigned)wid * 1024u;
    const int aoff = lds_byte(wr * 64 + fr, fq * 8), boff = lds_byte(wc * 32 + fr, fq * 8);
#define PG8_SA(b, h) (((b) * 2 + (h)) * HTB)
#define PG8_SB(b, h) ((4 + (b) * 2 + (h)) * HTB)
#define PG8_STAGE(bufoff, gbase, voff) do { _Pragma("unroll") for (int _i = 0; _i < 2; ++_i) \
        __builtin_amdgcn_global_load_lds((const unsigned*)((const char*)(gbase) + (voff)[_i]), (PG8_LAS unsigned*)(lds + (bufoff) + ldsw + _i * 8192), 16, 0, 0); } while (0)
#define PG8_LDA(dst, b, h) do { _Pragma("unroll") for (int m = 0; m < 4; ++m) _Pragma("unroll") for (int k = 0; k < 2; ++k) dst[m][k] = *(const PG8_LAS bf16x8*)(lds + PG8_SA(b, h) + aoff + m * 2048 + k * 1024); } while (0)
#define PG8_LDB(dst, b, h) do { _Pragma("unroll") for (int n = 0; n < 2; ++n) _Pragma("unroll") for (int k = 0; k < 2; ++k) dst[n][k] = *(const PG8_LAS bf16x8*)(lds + PG8_SB(b, h) + boff + n * 2048 + k * 1024); } while (0)
#define PG8_MMA(ai, bj, At, Bt) do { __builtin_amdgcn_s_setprio(1); _Pragma("unroll") for (int m = 0; m < 4; ++m) _Pragma("unroll") for (int n = 0; n < 2; ++n) _Pragma("unroll") for (int k = 0; k < 2; ++k) \
        acc[ai][bj][m][n] = __builtin_amdgcn_mfma_f32_16x16x32_bf16(Bt[n][k], At[m][k], acc[ai][bj][m][n], 0, 0, 0); __builtin_amdgcn_s_setprio(0); } while (0)
#define PG8_WAIT_V(n) asm volatile("s_waitcnt vmcnt(" #n ")" ::: "memory")
#define PG8_WAIT_L(n) asm volatile("s_waitcnt lgkmcnt(" #n ")" ::: "memory")
#define PG8_BAR __builtin_amdgcn_s_barrier()
#define PG8_SCHED __builtin_amdgcn_sched_barrier(0)
    Unit cur, nxt; int ui = 0;
    if (!S.next(0, cur)) return;
    f32x4 acc[2][2][4][2];
#pragma unroll
    for (int a = 0; a < 2; ++a)
#pragma unroll
        for (int b = 0; b < 2; ++b)
#pragma unroll
            for (int m = 0; m < 4; ++m)
#pragma unroll
                for (int n = 0; n < 2; ++n) acc[a][b][m][n] = (f32x4){0.f, 0.f, 0.f, 0.f};
    bf16x8 At[4][2], B0[2][2], B1[2][2];
    const char* cA = (const char*)g.A + (size_t)cur.pm * tstep; const char* cB = (const char*)g.Bt + (size_t)cur.pn * tstep;
    S.a_ready(cur);
    PG8_STAGE(PG8_SB(0, 0), cB, voffB); PG8_STAGE(PG8_SA(0, 0), cA, voffA); PG8_STAGE(PG8_SB(0, 1), cB + hstep, voffB); PG8_STAGE(PG8_SA(0, 1), cA + hstep, voffA);
    if (wr == 1) PG8_BAR;
    PG8_WAIT_V(4); PG8_BAR;
    PG8_STAGE(PG8_SB(1, 0), cB + kstep, voffB); PG8_STAGE(PG8_SA(1, 0), cA + kstep, voffA); PG8_STAGE(PG8_SB(1, 1), cB + hstep + kstep, voffB);
    PG8_WAIT_V(6); PG8_BAR;
    PG8_STAMP();
    for (;;) {
        const bool has_next = S.next(ui + 1, nxt);
        const char* nA = has_next ? (const char*)g.A + (size_t)nxt.pm * tstep : cA; const char* nB = has_next ? (const char*)g.Bt + (size_t)nxt.pn * tstep : cB;
        for (int t = 0; t < nt; t += 2) {
            const bool last = (t == nt - 2);
            const char* a1 = cA + (size_t)(t + 1) * kstep;
            const char* a2 = last ? nA : cA + (size_t)(t + 2) * kstep; const char* b2 = last ? nB : cB + (size_t)(t + 2) * kstep;
            const char* a3 = a2 + kstep; const char* b3 = b2 + kstep;
            if (last && has_next) S.a_ready(nxt);
            PG8_LDB(B0, 0, 0); PG8_SCHED; PG8_LDA(At, 0, 0); PG8_STAGE(PG8_SA(1, 1), a1 + hstep, voffA);
            PG8_WAIT_L(8); PG8_BAR; PG8_WAIT_L(0); PG8_MMA(0, 0, At, B0); PG8_BAR; PG8_SCHED;
            PG8_LDB(B1, 0, 1); PG8_STAGE(PG8_SB(0, 0), b2, voffB);
            PG8_BAR; PG8_WAIT_L(0); PG8_MMA(0, 1, At, B1); PG8_BAR;
            PG8_LDA(At, 0, 1); PG8_STAGE(PG8_SA(0, 0), a2, voffA);
            PG8_BAR; PG8_WAIT_L(0); PG8_MMA(1, 0, At, B0); PG8_BAR; PG8_SCHED;
            PG8_STAGE(PG8_SB(0, 1), b2 + hstep, voffB);
            PG8_WAIT_V(6); PG8_BAR; PG8_MMA(1, 1, At, B1); PG8_BAR;
            PG8_LDB(B0, 1, 0); PG8_SCHED; PG8_LDA(At, 1, 0); PG8_STAGE(PG8_SA(0, 1), a2 + hstep, voffA);
            PG8_WAIT_L(8); PG8_BAR; PG8_WAIT_L(0); PG8_MMA(0, 0, At, B0); PG8_BAR; PG8_SCHED;
            PG8_LDB(B1, 1, 1); PG8_STAGE(PG8_SB(1, 0), b3, voffB);
            PG8_BAR; PG8_WAIT_L(0); PG8_MMA(0, 1, At, B1); PG8_BAR;
            PG8_LDA(At, 1, 1); PG8_STAGE(PG8_SA(1, 0), a3, voffA);
            PG8_BAR; PG8_WAIT_L(0); PG8_MMA(1, 0, At, B0); PG8_BAR; PG8_SCHED;
            PG8_STAGE(PG8_SB(1, 1), b3 + hstep, voffB);
            PG8_WAIT_V(6); PG8_BAR; PG8_MMA(1, 1, At, B1); PG8_BAR;
        }
        PG8_STAMP();
        if constexpr (!Epi::AFTER_DRAIN) { E(acc, cur, wr, wc, fr, fq); S.done(cur); }
        PG8_STAMP();
        if (!has_next) break;
#pragma unroll
        for (int a = 0; a < 2; ++a)
#pragma unroll
            for (int b = 0; b < 2; ++b)
#pragma unroll
                for (int m = 0; m < 4; ++m)
#pragma unroll
                    for (int n = 0; n < 2; ++n) acc[a][b][m][n] = (f32x4){0.f, 0.f, 0.f, 0.f};
        cur = nxt; cA = nA; cB = nB; ++ui;
    }
    PG8_WAIT_V(0);
    if (wr == 0) PG8_BAR;
    PG8_BAR;
    if constexpr (Epi::AFTER_DRAIN) { E.fused(acc, cur, wr, wc, fr, fq, lds, wid, lane); S.done(cur); }
    PG8_STAMP();
    if (STAMP && wid == 0) { stamps[lane] = lane < nts ? (((unsigned long long)(unsigned)ts_hi << 32) | (unsigned)ts_lo) : 0ull;
        if (lane == 62) stamps[62] = rt_entry; if (lane == 63) stamps[63] = (unsigned long long)wall_clock64(); }
#undef PG8_STAMP
#undef PG8_SA
#undef PG8_SB
#undef PG8_STAGE
#undef PG8_LDA
#undef PG8_LDB
#undef PG8_MMA
#undef PG8_WAIT_V
#undef PG8_WAIT_L
#undef PG8_BAR
#undef PG8_SCHED
}
}
#define XB_TMO      128
#define XB_XCNT(j)  (256  + 64 * (j))
#define XB_XSUB(j)  (1280 + 64 * (j))
#define XB_XGEN(j)  (2304 + 64 * (j))
#define XB_TOP      3328
#define XB_TOPGEN   3392
#define XCD_BAR_WORDS 3456
#define XB_SPIN_CAP (1u << 24)

__device__ __forceinline__ unsigned xb_ld(unsigned* p)              { return __hip_atomic_load(p, __ATOMIC_RELAXED, __HIP_MEMORY_SCOPE_AGENT); }
__device__ __forceinline__ unsigned xb_add(unsigned* p, unsigned v) { return __hip_atomic_fetch_add(p, v, __ATOMIC_RELAXED, __HIP_MEMORY_SCOPE_AGENT); }
__device__ __forceinline__ unsigned xb_xcc_id() { return (unsigned)__builtin_amdgcn_s_getreg((3 << 11) | 20) & 0xFu; }
#define XB_SPIN(cond, bar) do { unsigned _sp = 0; while (cond) { __builtin_amdgcn_s_sleep(1); \
    if ((++_sp & 255u) == 0u) { if (xb_ld(&(bar)[XB_TMO])) break; if (_sp > XB_SPIN_CAP) { atomicAdd(&(bar)[XB_TMO], 1u); break; } } } } while (0)

struct XcdBarrier {
    unsigned* bar; unsigned x;
    volatile LAS unsigned* st;
};

__device__ __forceinline__ XcdBarrier xcd_barrier_post(unsigned* bar, volatile LAS unsigned* st) {
    XcdBarrier b; b.bar = bar; b.x = xb_xcc_id(); b.st = st;
    if (threadIdx.x == 0) (void)xb_add(&bar[XB_XCNT(b.x)], 1u);
    return b;
}
__device__ __forceinline__ void xcd_barrier_complete(unsigned* bar, unsigned x, unsigned& nloc, unsigned& nx) {
    const unsigned G = gridDim.x * gridDim.y * gridDim.z;
    unsigned sum, cnt, mine, sp = 0u;
    for (;;) {
        sum = 0u; cnt = 0u; mine = 0u;
#pragma unroll
        for (unsigned j = 0; j < 16; ++j) { const unsigned c = xb_ld(&bar[XB_XCNT(j)]); sum += c; cnt += (c > 0u) ? 1u : 0u; mine = (j == x) ? c : mine; }
        if (sum == G) break;
        __builtin_amdgcn_s_sleep(1);
        if ((++sp & 255u) == 0u) { if (xb_ld(&bar[XB_TMO])) break; if (sp > XB_SPIN_CAP) { atomicAdd(&bar[XB_TMO], 1u); break; } }
    }
    nloc = mine > 0u ? mine : 1u; nx = cnt > 0u ? cnt : 1u;
}

__device__ __forceinline__ void xcd_barrier(const XcdBarrier& b) {
    asm volatile("s_waitcnt vmcnt(0)" ::: "memory");
    __syncthreads();
    if (threadIdx.x == 0) {
        unsigned* bar = b.bar;
        __builtin_amdgcn_s_waitcnt(0);
        unsigned nloc = b.st[0], nx = b.st[1];
        if (nloc == 0u) { xcd_barrier_complete(bar, b.x, nloc, nx); b.st[0] = nloc; b.st[1] = nx; }
        const unsigned old = xb_add(&bar[XB_XSUB(b.x)], 1u);
        const unsigned gen = old / nloc;
        if (old + 1u == (gen + 1u) * nloc) {
            __builtin_amdgcn_fence(__ATOMIC_RELEASE, "agent");
            asm volatile("s_waitcnt vmcnt(0)" ::: "memory");
            const unsigned og = xb_add(&bar[XB_TOP], 1u);
            const unsigned tg = og / nx;
            if (og + 1u == (tg + 1u) * nx) xb_add(&bar[XB_TOPGEN], 1u);
            else XB_SPIN(xb_ld(&bar[XB_TOPGEN]) == tg, bar);
            __builtin_amdgcn_fence(__ATOMIC_ACQUIRE, "agent");
            xb_add(&bar[XB_XGEN(b.x)], 1u);
            asm volatile("s_waitcnt vmcnt(0)" ::: "memory");
        } else {
            XB_SPIN(xb_ld(&bar[XB_XGEN(b.x)]) == gen, bar);
            __builtin_amdgcn_fence(__ATOMIC_ACQUIRE, "agent");
            asm volatile("s_waitcnt vmcnt(0)" ::: "memory");
        }
    }
    __syncthreads();
}

constexpr int RING_OFF = 0, RING_BYTES = 131072;
constexpr int LDSCTL_OFF = RING_BYTES, MISC_OFF = LDSCTL_OFF + 320;
constexpr int LDS_BYTES = 147456;
constexpr int NWAVES = 8, NTHREADS = 512;
constexpr int CW_BAR = 4096;

typedef unsigned u32x4_t __attribute__((ext_vector_type(4)));
typedef float f32x4_t __attribute__((ext_vector_type(4)));
typedef short bf16x8_t __attribute__((ext_vector_type(8)));

__device__ __forceinline__ void p0_transpose_item(const float* W, int ldw, int K, int col0, int k0, bf16_t* WT, int wt_row0, LAS float* scr, int lane) {
#pragma unroll 8
    for (int i = 0; i < 32; ++i) { const int kk = 2 * i + (lane >> 5); scr[kk * 33 + (lane & 31)] = W[(size_t)(k0 + kk) * ldw + col0 + (lane & 31)]; }
    asm volatile("s_waitcnt lgkmcnt(0)" ::: "memory");
    const int c = lane & 7;
#pragma unroll
    for (int j = 0; j < 4; ++j) { const int n = (lane >> 3) + 8 * j; const LAS float* s = scr + (8 * c) * 33 + n;
        u32x4_t o; o.x = pk2(s[0 * 33], s[1 * 33]); o.y = pk2(s[2 * 33], s[3 * 33]); o.z = pk2(s[4 * 33], s[5 * 33]); o.w = pk2(s[6 * 33], s[7 * 33]);
        *(u32x4_t*)(WT + (size_t)(wt_row0 + n) * K + k0 + 8 * c) = o; }
    asm volatile("s_waitcnt lgkmcnt(0)" ::: "memory");
}
__device__ __forceinline__ float wave_sum(float v) {
#pragma unroll
    for (int o = 1; o < 64; o <<= 1) v += __shfl_xor(v, o);
    return v;
}

struct Args {
    const float* x_prompt; const float* x_sample; const float* cache_k; const float* cache_v; const float* cache_logf; const int* page_table;
    const float* state_ssm; const float* state_conv; const float* w_in; const float* conv_w; const float* a_log; const float* dt_bias;
    const float* onorm_w; const float* f_bias; const float* w_out; const float* norm_w; const float* final_norm_w;
    float* out; unsigned char* ws; int ph_lo, ph_hi;
};

__global__ void __launch_bounds__(NTHREADS, 2) mega(Args a) {
    extern __shared__ __attribute__((aligned(16))) unsigned char lds_raw[];
    LAS unsigned char* lds = (LAS unsigned char*)lds_raw;
    const int tid = threadIdx.x, lane = tid & 63, wave = __builtin_amdgcn_readfirstlane(tid >> 6);
    const int G = gridDim.x, gw = blockIdx.x * NWAVES + wave, NGW = G * NWAVES;
    unsigned char* ws = a.ws;
    for (int u = tid; u < (LDS_BYTES - LDSCTL_OFF) / 4; u += NTHREADS) ((LAS unsigned*)(lds + LDSCTL_OFF))[u] = 0u;
    __syncthreads();
    XcdBarrier bar = xcd_barrier_post((unsigned*)(ws + W_CTL) + CW_BAR, (volatile LAS unsigned*)(lds + MISC_OFF) + 8);
    const int lo = a.ph_lo, hi = a.ph_hi;
#define IN(k) (lo <= (k) && (k) < hi)
#define BOTH(k) (IN(k) && IN((k) + 1))

    if (IN(0)) {
        bf16_t* WINT = (bf16_t*)(ws + W_WINT); bf16_t* WSM = (bf16_t*)(ws + W_WSM); bf16_t* WOUT = (bf16_t*)(ws + W_WOUT); bf16_t* HB = (bf16_t*)(ws + W_HB);
        LAS float* scr = (LAS float*)(lds + RING_OFF + wave * 16384);
        constexpr int I_IN = (D_MODEL / 64) * (4096 / 32), I_OUT = (D_MODEL / 64) * (D_MODEL / 32);
        for (int it = gw; it < I_IN + I_OUT; it += NGW) {
            if (it < I_IN) { const int kb = it / 128, nb = it % 128, n0 = 32 * nb; const int col0 = n0 < 2048 ? n0 : n0 + 8;
                p0_transpose_item(a.w_in, D_IN, D_MODEL, col0, 64 * kb, WINT, n0, scr, lane); }
            else { const int r = it - I_IN, kb = r / 32, nb = r % 32;
                p0_transpose_item(a.w_out, D_MODEL, D_MODEL, 32 * nb, 64 * kb, WOUT, 32 * nb, scr, lane); }
        }
        for (int i = blockIdx.x * NTHREADS + tid; i < 16 * D_MODEL; i += G * NTHREADS) {
            const int n = i >> 10, k = i & 1023; float v = 0.f;
            if (n < 8) v = a.w_in[(size_t)k * D_IN + C_BG + n]; else if (n < 12) v = a.w_in[(size_t)k * D_IN + C_FF + (n - 8)];
            WSM[i] = (bf16_t)f2bf(v);
        }
        for (int m = gw; m < MT; m += NGW) {
            const f32x4_t* xr = (const f32x4_t*)xrow(a.x_prompt, a.x_sample, m) + lane;
            const f32x4_t* wr4 = (const f32x4_t*)a.norm_w + lane;
            f32x4_t v[4]; float s = 0.f;
#pragma unroll
            for (int j = 0; j < 4; ++j) { v[j] = xr[64 * j]; s += (v[j].x * v[j].x + v[j].y * v[j].y) + (v[j].z * v[j].z + v[j].w * v[j].w); }
            const float rstd = rsqrtf(wave_sum(s) * (1.f / D_MODEL) + 1e-6f);
            unsigned long long* o8 = (unsigned long long*)(HB + (size_t)m * D_MODEL) + lane;
#pragma unroll
            for (int j = 0; j < 4; ++j) { const f32x4_t w4 = wr4[64 * j];
                o8[64 * j] = (unsigned long long)pk2(v[j].x * rstd * w4.x, v[j].y * rstd * w4.y) | ((unsigned long long)pk2(v[j].z * rstd * w4.z, v[j].w * rstd * w4.w) << 32); }
        }
        if (BOTH(0)) xcd_barrier(bar);
    }

    if (IN(1)) {
        bf16_t* WINT = (bf16_t*)(ws + W_WINT); bf16_t* WSM = (bf16_t*)(ws + W_WSM); bf16_t* HB = (bf16_t*)(ws + W_HB);
        bf16_t* QKVG = (bf16_t*)(ws + W_QKVG); bf16_t* ZG = (bf16_t*)(ws + W_ZG); bf16_t* ZF = (bf16_t*)(ws + W_ZF);
        bf16_t* QFP = (bf16_t*)(ws + W_QFP); bf16_t* KFP = (bf16_t*)(ws + W_KFP); bf16_t* VFP = (bf16_t*)(ws + W_VFP); bf16_t* QFS = (bf16_t*)(ws + W_QFS);
        float* BETA = (float*)(ws + W_BETA); float* GG = (float*)(ws + W_G); float* LOGF = (float*)(ws + W_LOGF);
        pg8::Gemm g{HB, WINT, MT, 4096, D_MODEL}; pg8::StaticOrder S; S.init(MT, 4096, G, (int)blockIdx.x);
        pg8::EpiProj E{QKVG, ZG, ZF, QFP, KFP, VFP, QFS, a.out};
        pg8::gemm_phase<pg8::EpiProj, pg8::StaticOrder, false>(lds + RING_OFF, g, S, E, nullptr);
        for (int tile = gw; tile < MT / 16; tile += NGW) {
            const int row0 = tile * 16;
            f32x4_t acc = {0.f, 0.f, 0.f, 0.f};
            const bf16_t* ap = HB + (size_t)(row0 + (lane & 15)) * D_MODEL + 8 * (lane >> 4);
            const bf16_t* bp = WSM + (size_t)(lane & 15) * D_MODEL + 8 * (lane >> 4);
#pragma unroll 8
            for (int kk = 0; kk < 32; ++kk) { const bf16x8_t av = *(const bf16x8_t*)(ap + 32 * kk), bv = *(const bf16x8_t*)(bp + 32 * kk);
                acc = __builtin_amdgcn_mfma_f32_16x16x32_bf16(av, bv, acc, 0, 0, 0); }
            const int col = lane & 15;
#pragma unroll
            for (int j = 0; j < 4; ++j) {
                const int row = row0 + 4 * (lane >> 4) + j; const float v = acc[j];
                if (col < 4) BETA[row * 4 + col] = sigmoidf_(v);
                else if (col < 8) GG[row * 4 + (col - 4)] = -expf(a.a_log[col - 4]) * softplusf_(v + a.dt_bias[col - 4]);
                else if (col < 12) { const float lf = logsigmoidf_(v + a.f_bias[col - 8]); LOGF[row * 4 + (col - 8)] = lf;
                    if (row < MP) a.out[O_LP + (size_t)row * 4 + (col - 8)] = lf; else a.out[O_LS + (size_t)(row - MP) * 4 + (col - 8)] = lf; }
            }
        }
        if (BOTH(1)) xcd_barrier(bar);
    }

    if (IN(2)) {
        const bf16_t* QKVG = (const bf16_t*)(ws + W_QKVG); float* QKVC = (float*)(ws + W_QKVC);
        const float* LOGF = (const float*)(ws + W_LOGF); float* F = (float*)(ws + W_F); float* FP = (float*)(ws + W_FP);
        for (size_t i = (size_t)blockIdx.x * NTHREADS + tid; i < (size_t)MT * CONV_DIM; i += (size_t)G * NTHREADS) {
            const int row = (int)(i / CONV_DIM), c = (int)(i % CONV_DIM);
            int b, tt; const bool samp = row >= MP;
            if (!samp) { b = row / SEQ; tt = row % SEQ; } else { b = (row - MP) / DEC_SEQ; tt = (row - MP) % DEC_SEQ; }
            float y = 0.f;
#pragma unroll
            for (int j = 0; j < 4; ++j) {
                const int ts = tt - 3 + j; float xv;
                if (ts >= 0) xv = bf2f(QKVG[(size_t)(row - tt + ts) * CONV_DIM + c]);
                else xv = samp ? a.state_conv[((size_t)b * 3 + (3 + ts)) * CONV_DIM + c] : 0.f;
                y = fmaf(a.conv_w[j * CONV_DIM + c], xv, y);
            }
            QKVC[i] = siluf_(y);
        }
        for (int ch = gw; ch < BATCH * 4 + DEC_BATCH * 4; ch += NGW) {
            float v[32]; float run = 0.f;
            if (ch < BATCH * 4) { const int b = ch >> 2, h = ch & 3;
#pragma unroll
                for (int i = 0; i < 32; ++i) { run += LOGF[((size_t)b * SEQ + 32 * lane + i) * 4 + h]; v[i] = run; } }
            else { const int c2 = ch - BATCH * 4, b = c2 >> 2, h = c2 & 3; const int pg = a.page_table[b * NPAGES + (lane >> 2)];
#pragma unroll
                for (int i = 0; i < 32; ++i) { run += a.cache_logf[((size_t)pg * PAGE + ((32 * lane + i) & 127)) * 4 + h]; v[i] = run; } }
            float incl = run;
#pragma unroll
            for (int o = 1; o < 64; o <<= 1) { const float t2 = __shfl_up(incl, o); if (lane >= o) incl += t2; }
            const float excl = incl - run;
            if (ch < BATCH * 4) { const int b = ch >> 2, h = ch & 3;
#pragma unroll
                for (int i = 0; i < 32; ++i) F[((size_t)b * SEQ + 32 * lane + i) * 4 + h] = v[i] + excl; }
            else { const int c2 = ch - BATCH * 4, b = c2 >> 2, h = c2 & 3;
#pragma unroll
                for (int i = 0; i < 32; ++i) FP[((size_t)b * 4 + h) * PAST + 32 * lane + i] = v[i] + excl;
                if (lane == 63) { float acc = incl; for (int t = 0; t < DEC_SEQ; ++t) { const int row = MP + b * DEC_SEQ + t; acc += LOGF[row * 4 + h]; F[row * 4 + h] = acc; } } }
        }
        if (BOTH(2)) xcd_barrier(bar);
    }

    if (IN(3)) {
        const float* QKVC = (const float*)(ws + W_QKVC); const float* BETA = (const float*)(ws + W_BETA); const float* GG = (const float*)(ws + W_G);
        const bf16_t* ZG = (const bf16_t*)(ws + W_ZG); bf16_t* OMIX = (bf16_t*)(ws + W_OMIX);
        {
            const int half2 = tid >> 8, t8 = tid & 255, dv = t8 & 127, half = t8 >> 7;
            LAS float* sm = (LAS float*)(lds + RING_OFF) + half2 * 1024;
            LAS float* sq = sm; LAS float* sk = sm + 128; LAS float* sv = sm + 256; LAS float* sp = sm + 384; LAS float* sn = sm + 640;
            for (int it = blockIdx.x * 2 + half2; it < (BATCH + DEC_BATCH) * 4; it += 2 * G) {
                const int h = it & 3, sidx = it >> 2; const bool samp = sidx >= BATCH; const int b = samp ? sidx - BATCH : sidx;
                const int L = samp ? DEC_SEQ : SEQ; const int row0 = samp ? MP + b * DEC_SEQ : b * SEQ;
                float S[64];
                if (samp) { const float* s0 = a.state_ssm + ((size_t)(b * 4 + h) * 128) * 128;
#pragma unroll
                    for (int i = 0; i < 64; ++i) S[i] = s0[(size_t)(64 * half + i) * 128 + dv]; }
                else {
#pragma unroll
                    for (int i = 0; i < 64; ++i) S[i] = 0.f; }
                for (int t = 0; t < L; ++t) {
                    const int row = row0 + t; const float* qc = QKVC + (size_t)row * CONV_DIM;
                    if (half == 0) { sq[dv] = qc[h * 128 + dv]; sv[dv] = qc[1024 + h * 128 + dv]; } else { sk[dv] = qc[512 + h * 128 + dv]; }
                    __syncthreads();
                    if (t8 < 64) { float x = sq[t8] * sq[t8] + sq[t8 + 64] * sq[t8 + 64]; for (int o = 32; o >= 1; o >>= 1) x += __shfl_xor(x, o); if (t8 == 0) sn[0] = rsqrtf(x + 1e-6f) * 0.08838834764831845f; }
                    else if (t8 < 128) { const int l = t8 - 64; float x = sk[l] * sk[l] + sk[l + 64] * sk[l + 64]; for (int o = 32; o >= 1; o >>= 1) x += __shfl_xor(x, o); if (l == 0) sn[1] = rsqrtf(x + 1e-6f); }
                    __syncthreads();
                    const float qs = sn[0], ks = sn[1], al = expf(GG[row * 4 + h]), beta = BETA[row * 4 + h];
                    float p = 0.f;
#pragma unroll
                    for (int i = 0; i < 64; ++i) { S[i] *= al; p = fmaf(S[i], sk[64 * half + i] * ks, p); }
                    sp[half * 128 + dv] = p;
                    __syncthreads();
                    const float r = sv[dv] - (sp[dv] + sp[128 + dv]);
                    __syncthreads();
                    float po = 0.f;
#pragma unroll
                    for (int i = 0; i < 64; ++i) { S[i] = fmaf(beta * (sk[64 * half + i] * ks), r, S[i]); po = fmaf(S[i], sq[64 * half + i] * qs, po); }
                    sp[half * 128 + dv] = po;
                    __syncthreads();
                    if (t8 < 64) { const float o0 = sp[t8] + sp[128 + t8], o1 = sp[t8 + 64] + sp[128 + t8 + 64];
                        float ss = o0 * o0 + o1 * o1; for (int o = 32; o >= 1; o >>= 1) ss += __shfl_xor(ss, o);
                        const float rr = rsqrtf(ss * (1.f / 128.f) + 1e-6f);
                        const bf16_t* z = ZG + (size_t)row * 512 + h * 128; bf16_t* om = OMIX + (size_t)row * 1024 + h * 128;
                        om[t8] = (bf16_t)f2bf(o0 * rr * a.onorm_w[t8] * siluf_(bf2f(z[t8])));
                        om[t8 + 64] = (bf16_t)f2bf(o1 * rr * a.onorm_w[t8 + 64] * siluf_(bf2f(z[t8 + 64]))); }
                    __syncthreads();
                }
                float* so = samp ? a.out + O_SSMS + ((size_t)(b * 4 + h) * 128) * 128 : a.out + O_SSMP + ((size_t)(b * 4 + h) * 128) * 128;
#pragma unroll
                for (int i = 0; i < 64; ++i) so[(size_t)(64 * half + i) * 128 + dv] = S[i];
            }
        }
        __syncthreads();
        {
            const bf16_t* QFP = (const bf16_t*)(ws + W_QFP); const bf16_t* QFS = (const bf16_t*)(ws + W_QFS); const bf16_t* ZF = (const bf16_t*)(ws + W_ZF);
            const float* F = (const float*)(ws + W_F); const float* FP = (const float*)(ws + W_FP);
            LAS float* sc = (LAS float*)(lds + RING_OFF) + wave * 2304; LAS float* qsh = sc + 2176;
            for (int it = gw; it < MT * 4; it += NGW) {
                const int row = it >> 2, h = it & 3; const int l = lane;
                const bool samp = row >= MP;
                int b, tt; if (!samp) { b = row / SEQ; tt = row % SEQ; } else { b = (row - MP) / DEC_SEQ; tt = (row - MP) % DEC_SEQ; }
                const int nk = samp ? PAST + tt + 1 : tt + 1;
                const bf16_t* q = samp ? QFS + ((size_t)(b * 4 + h) * DEC_SEQ + tt) * HD : QFP + ((size_t)(b * 4 + h) * SEQ + tt) * HD;
                qsh[l] = bf2f(q[l]); qsh[l + 64] = bf2f(q[l + 64]);
                asm volatile("s_waitcnt lgkmcnt(0)" ::: "memory");
                const float fq = F[row * 4 + h];
                float mx = -INFINITY;
                for (int s = l; s < nk; s += 64) {
                    const float* kp; float fk;
                    if (!samp) { kp = a.out + O_KP + (size_t)(b * SEQ + s) * 512 + h * 128; fk = F[(b * SEQ + s) * 4 + h]; }
                    else if (s < PAST) { const int pg = a.page_table[b * NPAGES + (s >> 7)]; kp = a.cache_k + (((size_t)pg * PAGE + (s & 127)) * 4 + h) * 128; fk = FP[((size_t)b * 4 + h) * PAST + s]; }
                    else { const int r2 = MP + b * DEC_SEQ + (s - PAST); kp = a.out + O_KS + (size_t)(r2 - MP) * 512 + h * 128; fk = F[r2 * 4 + h]; }
                    float d = 0.f;
                    for (int i = 0; i < 32; ++i) { const float4 kv = ((const float4*)kp)[i]; d = fmaf(kv.x, qsh[4 * i], d); d = fmaf(kv.y, qsh[4 * i + 1], d); d = fmaf(kv.z, qsh[4 * i + 2], d); d = fmaf(kv.w, qsh[4 * i + 3], d); }
                    const float s_ = d * 0.08838834764831845f + (fq - fk);
                    sc[s] = s_; mx = fmaxf(mx, s_);
                }
                for (int o = 32; o >= 1; o >>= 1) mx = fmaxf(mx, __shfl_xor(mx, o));
                float sum = 0.f;
                for (int s = l; s < nk; s += 64) { const float p = expf(sc[s] - mx); sc[s] = p; sum += p; }
                for (int o = 32; o >= 1; o >>= 1) sum += __shfl_xor(sum, o);
                asm volatile("s_waitcnt lgkmcnt(0)" ::: "memory");
                float o0 = 0.f, o1 = 0.f;
                for (int s = 0; s < nk; ++s) {
                    const float* vp;
                    if (!samp) vp = a.out + O_VP + (size_t)(b * SEQ + s) * 512 + h * 128;
                    else if (s < PAST) { const int pg = a.page_table[b * NPAGES + (s >> 7)]; vp = a.cache_v + (((size_t)pg * PAGE + (s & 127)) * 4 + h) * 128; }
                    else vp = a.out + O_VS + (size_t)(b * DEC_SEQ + (s - PAST)) * 512 + h * 128;
                    const float p = sc[s];
                    o0 = fmaf(p, vp[l], o0); o1 = fmaf(p, vp[l + 64], o1);
                }
                const float inv = 1.f / sum;
                const bf16_t* z = ZF + (size_t)row * 512 + h * 128;
                bf16_t* om = OMIX + (size_t)row * 1024 + 512 + h * 128;
                om[l] = (bf16_t)f2bf(o0 * inv * siluf_(bf2f(z[l]))); om[l + 64] = (bf16_t)f2bf(o1 * inv * siluf_(bf2f(z[l + 64])));
                asm volatile("s_waitcnt lgkmcnt(0)" ::: "memory");
            }
        }
        xcd_barrier(bar);
    }

    if (IN(5)) {
        bf16_t* WOUT = (bf16_t*)(ws + W_WOUT); bf16_t* OMIX = (bf16_t*)(ws + W_OMIX); float* YPRE = (float*)(ws + W_YPRE); float* PART = (float*)(ws + W_PART);
        pg8::Gemm g{OMIX, WOUT, MT, D_MODEL, D_MODEL}; pg8::StaticOrder S; S.init(MT, D_MODEL, G, (int)blockIdx.x);
        pg8::EpiOut E{a.x_prompt, a.x_sample, YPRE, PART};
        pg8::gemm_phase<pg8::EpiOut, pg8::StaticOrder, false>(lds + RING_OFF, g, S, E, nullptr);
        if (BOTH(5)) xcd_barrier(bar);
    }

    if (IN(6)) {
        float* YPRE = (float*)(ws + W_YPRE); float* PART = (float*)(ws + W_PART);
        for (int m = gw; m < MT; m += NGW) {
            float p = PART[(size_t)m * 16 + (lane & 15)];
            p += __shfl_xor(p, 1); p += __shfl_xor(p, 2); p += __shfl_xor(p, 4); p += __shfl_xor(p, 8);
            const float rstd = rsqrtf(p * (1.f / D_MODEL) + 1e-6f);
            const f32x4_t* yr = (const f32x4_t*)(YPRE + (size_t)m * D_MODEL) + lane;
            const f32x4_t* wr4 = (const f32x4_t*)a.final_norm_w + lane;
            f32x4_t* o = (f32x4_t*)(m < MP ? a.out + O_YP + (size_t)m * D_MODEL : a.out + O_YS + (size_t)(m - MP) * D_MODEL) + lane;
#pragma unroll
            for (int j = 0; j < 4; ++j) o[64 * j] = yr[64 * j] * rstd * wr4[64 * j];
        }
    }
#undef IN
#undef BOTH
}

extern "C" void kernel_launch(void* const* d_in, const int* in_sizes, int n_in, void* d_out, int out_size, void* d_ws, size_t ws_size, hipStream_t stream) {
    static int grid = 0;
    if (grid == 0) {
        if (n_in != 17 || (size_t)out_size != O_END || ws_size < W_END) { fprintf(stderr, "kernel_launch: unexpected shapes\n"); grid = -1; return; }
        int dev = 0, cus = 0;
        if (hipGetDevice(&dev) != hipSuccess || hipDeviceGetAttribute(&cus, hipDeviceAttributeMultiprocessorCount, dev) != hipSuccess) { grid = -1; return; }
        if (hipFuncSetAttribute((const void*)mega, hipFuncAttributeMaxDynamicSharedMemorySize, LDS_BYTES) != hipSuccess) { fprintf(stderr, "kernel_launch: hipFuncSetAttribute failed\n"); grid = -1; return; }
        int per_cu = 0;
        if (hipOccupancyMaxActiveBlocksPerMultiprocessor(&per_cu, (const void*)mega, NTHREADS, LDS_BYTES) != hipSuccess || per_cu < 1) fprintf(stderr, "kernel_launch: occupancy query says %d\n", per_cu);
        (void)hipGetLastError();
        grid = cus;
    }
    if (grid < 0) return;
    Args a{};
    a.x_prompt = (const float*)d_in[0]; a.x_sample = (const float*)d_in[1]; a.cache_k = (const float*)d_in[2]; a.cache_v = (const float*)d_in[3]; a.cache_logf = (const float*)d_in[4];
    a.page_table = (const int*)d_in[5]; a.state_ssm = (const float*)d_in[6]; a.state_conv = (const float*)d_in[7]; a.w_in = (const float*)d_in[8]; a.conv_w = (const float*)d_in[9];
    a.a_log = (const float*)d_in[10]; a.dt_bias = (const float*)d_in[11]; a.onorm_w = (const float*)d_in[12]; a.f_bias = (const float*)d_in[13]; a.w_out = (const float*)d_in[14];
    a.norm_w = (const float*)d_in[15]; a.final_norm_w = (const float*)d_in[16]; a.out = (float*)d_out; a.ws = (unsigned char*)d_ws;
    unsigned char* ws = (unsigned char*)d_ws;
    (void)hipMemsetAsync(ws + W_CTL, 0, CTL_BYTES, stream);
    auto launch = [&](int lo, int hi) { a.ph_lo = lo; a.ph_hi = hi; hipLaunchKernelGGL(mega, dim3(grid), dim3(NTHREADS), LDS_BYTES, stream, a); };
    launch(0, 7);
}
```

```cpp
#include <hip/hip_runtime.h>
#include <stdint.h>
#include <cstdio>

constexpr int D_MODEL = 1024, BATCH = 8, SEQ = 2048, DEC_BATCH = 128, DEC_SEQ = 4, PAST = 2048, PAGE = 128, NPAGES = 16;
constexpr int HD = 128, NH = 4;
constexpr int CONV_DIM = 1536, D_IN = 4108;
constexpr int MP = BATCH * SEQ, MS = DEC_BATCH * DEC_SEQ, MT = MP + MS;
constexpr int C_QKVG = 0, C_ZG = 1536, C_BG = 2048, C_AG = 2052, C_QF = 2056, C_KF = 2568, C_VF = 3080, C_ZF = 3592, C_FF = 4104;
constexpr size_t O_YP = 0, O_YS = O_YP + (size_t)MP * 1024, O_KP = O_YS + (size_t)MS * 1024, O_VP = O_KP + (size_t)MP * 512,
                 O_LP = O_VP + (size_t)MP * 512, O_SSMP = O_LP + (size_t)MP * 4, O_CONVP = O_SSMP + (size_t)BATCH * 4 * 128 * 128,
                 O_KS = O_CONVP + (size_t)BATCH * 3 * 1536, O_VS = O_KS + (size_t)MS * 512, O_LS = O_VS + (size_t)MS * 512,
                 O_SSMS = O_LS + (size_t)MS * 4, O_CONVS = O_SSMS + (size_t)DEC_BATCH * 4 * 128 * 128, O_END = O_CONVS + (size_t)DEC_BATCH * 3 * 1536;
constexpr size_t MiB = 1u << 20;
constexpr size_t W_CTL = 0, CTL_BYTES = 1 * MiB;
constexpr size_t W_WINT = 2 * MiB;
constexpr size_t W_WSM = W_WINT + 8 * MiB;
constexpr size_t W_WOUT = W_WSM + 1 * MiB;
constexpr size_t W_HB = W_WOUT + 2 * MiB;
constexpr size_t W_QKVG = W_HB + 34 * MiB;
constexpr size_t W_ZG = W_QKVG + 50 * MiB;
constexpr size_t W_ZF = W_ZG + 17 * MiB;
constexpr size_t W_QFP = W_ZF + 17 * MiB;
constexpr size_t W_KFP = W_QFP + 16 * MiB;
constexpr size_t W_VFP = W_KFP + 16 * MiB;
constexpr size_t W_QFS = W_VFP + 16 * MiB;
constexpr size_t W_BETA = W_QFS + 1 * MiB;
constexpr size_t W_G = W_BETA + 1 * MiB;
constexpr size_t W_LOGF = W_G + 1 * MiB;
constexpr size_t W_F = W_LOGF + 1 * MiB;
constexpr size_t W_FP = W_F + 1 * MiB;
constexpr size_t W_GPL = W_FP + 4 * MiB;
constexpr size_t W_FPL = W_GPL + 1 * MiB;
constexpr size_t W_FNL = W_FPL + 4 * MiB;
constexpr size_t W_OMIX = W_FNL + 1 * MiB;
constexpr size_t W_YPRE = W_OMIX + 34 * MiB;
constexpr size_t W_PART = W_YPRE + 67 * MiB;
constexpr size_t W_WN = W_PART + 2 * MiB;
constexpr size_t W_QD = W_WN + 16 * MiB;
constexpr size_t W_KDT = W_QD + 16 * MiB;
constexpr size_t W_QKM = W_KDT + 16 * MiB;
constexpr size_t W_UT = W_QKM + 8 * MiB;
constexpr size_t W_GL = W_UT + 32 * MiB;
constexpr size_t W_END = W_GL + 1 * MiB;

#define LAS __attribute__((address_space(3)))
typedef unsigned short bf16_t;
__device__ __forceinline__ float sigmoidf_(float x) { return 1.f / (1.f + expf(-x)); }
__device__ __forceinline__ float siluf_(float x) { return x / (1.f + expf(-x)); }
__device__ __forceinline__ float softplusf_(float x) { return fmaxf(x, 0.f) + log1pf(expf(-fabsf(x))); }
__device__ __forceinline__ float logsigmoidf_(float x) { return -softplusf_(-x); }
__device__ __forceinline__ float bf2f(bf16_t b) { return __uint_as_float(((unsigned)b) << 16); }
__device__ __forceinline__ unsigned f2bf(float f) { unsigned u = __float_as_uint(f); return (u + 0x7fffu + ((u >> 16) & 1u)) >> 16; }
__device__ __forceinline__ unsigned pk2(float lo, float hi) { return f2bf(lo) | (f2bf(hi) << 16); }
__device__ __forceinline__ const float* xrow(const float* xp, const float* xs, int row) {
    return row < MP ? xp + (size_t)row * D_MODEL : xs + (size_t)(row - MP) * D_MODEL;
}

namespace pg8 {
#define PG8_LAS __attribute__((address_space(3)))
typedef unsigned short bf16_t;
typedef short bf16x8 __attribute__((ext_vector_type(8)));
typedef float f32x4 __attribute__((ext_vector_type(4)));
typedef unsigned u32x4 __attribute__((ext_vector_type(4)));
constexpr int BM = 256, BK = 64, HALF = 128, HTB = HALF * BK * 2  , STAGE_BYTES = 8 * HTB, NXCD = 8, WGM = 8;

__host__ __device__ __forceinline__ int lds_byte(int r, int c) { const int st = (r >> 4) * 2 + (c >> 5), rr = r & 15, cc = c & 31, ob = rr * 64 + cc * 2; return st * 1024 + (ob ^ (((ob >> 9) & 1) << 5)); }
__host__ __device__ __forceinline__ void stage_rc(int b, int& R, int& C) { const int st = b / 1024, sb = b % 1024, swz = sb ^ (((sb >> 9) & 1) << 5); R = (st >> 1) * 16 + swz / 64; C = (st & 1) * 32 + (swz % 64) / 2; }
__host__ __device__ __forceinline__ int perm32(int rho) { const int n = rho >> 4, i = rho & 15; return 8 * (i >> 2) + 4 * n + (i & 3); }

struct Unit { int pm, pn; };
struct Gemm { const bf16_t* A; const bf16_t* Bt; int M, N, K; };

struct StaticOrder {
    int nM, nN, nwg, G, c;
    __host__ __device__ void init(int M, int N, int G_, int c_) { nM = M / BM; nN = N / BM; nwg = nM * nN; G = G_; c = c_; }
    __host__ __device__ bool next(int i, Unit& u) const {
        const long L = (long)i * G + c; if (L >= nwg) return false;
        int wgid = (int)L; { const int q = nwg / NXCD, r = nwg % NXCD, xcd = wgid % NXCD, off = wgid / NXCD; wgid = (xcd < r ? xcd * (q + 1) : r * (q + 1) + (xcd - r) * q) + off; }
        const int nig = WGM * nN, gid = wgid / nig, fm = gid * WGM, gsz = (nM - fm) < WGM ? (nM - fm) : WGM;
        u.pm = fm + ((wgid % nig) % gsz); u.pn = (wgid % nig) / gsz; return true;
    }
    __device__ __forceinline__ void a_ready(const Unit&) const {}
    __device__ __forceinline__ void done(const Unit&) const {}
};

__device__ __forceinline__ unsigned cvt_pk_bf16(float lo, float hi) { unsigned r; asm volatile("v_cvt_pk_bf16_f32 %0, %1, %2" : "=v"(r) : "v"(lo), "v"(hi)); return r; }
__device__ __forceinline__ u32x4 pack8(const f32x4 v0, const f32x4 v1) { u32x4 w; w.x = cvt_pk_bf16(v0[0], v0[1]); w.y = cvt_pk_bf16(v0[2], v0[3]); w.z = cvt_pk_bf16(v1[0], v1[1]); w.w = cvt_pk_bf16(v1[2], v1[3]); return w; }

struct EpiProj {
    static constexpr bool PERM = true, AFTER_DRAIN = false;
    bf16_t* QKVG; bf16_t* ZG; bf16_t* ZF; bf16_t* QFP; bf16_t* KFP; bf16_t* VFP; bf16_t* QFS; float* out;
    __device__ __forceinline__ void operator()(const f32x4 (&acc)[2][2][4][2], const Unit& u, int wr, int wc, int fr, int fq) const {
        const int pn = u.pn; const bool samp = u.pm >= (MP / 256);
        const int rbase = u.pm * BM + wr * 64 + fr, cb = wc * 32 + 8 * fq;
        if (pn < 6) {
            const int c0 = pn * BM + cb;
#pragma unroll
            for (int ai = 0; ai < 2; ++ai)
#pragma unroll
                for (int m = 0; m < 4; ++m) {
                    const int row = rbase + ai * HALF + m * 16;
                    bf16_t* p = QKVG + (size_t)row * CONV_DIM + c0;
                    *(u32x4*)p = pack8(acc[ai][0][m][0], acc[ai][0][m][1]); *(u32x4*)(p + HALF) = pack8(acc[ai][1][m][0], acc[ai][1][m][1]);
                    int j = -1; size_t cob = 0;
                    if (!samp) { const int t = row & 2047; if (t >= SEQ - 3) { j = t - (SEQ - 3); cob = O_CONVP + (size_t)(row >> 11) * 3 * CONV_DIM; } }
                    else { const int r = row - MP, t = r & 3; if (t >= 1) { j = t - 1; cob = O_CONVS + (size_t)(r >> 2) * 3 * CONV_DIM; } }
                    if (j >= 0) { float* co = out + cob + (size_t)j * CONV_DIM + c0;
                        *(f32x4*)co = acc[ai][0][m][0]; *(f32x4*)(co + 4) = acc[ai][0][m][1]; *(f32x4*)(co + HALF) = acc[ai][1][m][0]; *(f32x4*)(co + HALF + 4) = acc[ai][1][m][1]; }
                    asm volatile("" ::: "memory");
                }
        } else if (pn < 8 || pn >= 14) {
            bf16_t* Z = ZG + (pn < 8 ? (size_t)0 : (size_t)((W_ZF - W_ZG) / 2)); const int c0 = (pn < 8 ? pn - 6 : pn - 14) * BM + cb;
#pragma unroll
            for (int ai = 0; ai < 2; ++ai)
#pragma unroll
                for (int m = 0; m < 4; ++m) {
                    const int row = rbase + ai * HALF + m * 16;
                    bf16_t* p = Z + (size_t)row * 512 + c0;
                    *(u32x4*)p = pack8(acc[ai][0][m][0], acc[ai][0][m][1]); *(u32x4*)(p + HALF) = pack8(acc[ai][1][m][0], acc[ai][1][m][1]);
                    asm volatile("" ::: "memory");
                }
        } else {
            const int kind = (pn - 8) >> 1, head0 = ((pn - 8) & 1) * 2;
            bf16_t* HP = QFP + (size_t)kind * ((W_KFP - W_QFP) / 2);
            const size_t ob = kind == 1 ? (samp ? O_KS : O_KP) : (samp ? O_VS : O_VP);
#pragma unroll
            for (int ai = 0; ai < 2; ++ai)
#pragma unroll
                for (int m = 0; m < 4; ++m) {
                    const int row = rbase + ai * HALF + m * 16;
                    if (kind != 0) { float* o = out + ob + (size_t)(samp ? row - MP : row) * 512 + head0 * HD + cb;
                        *(f32x4*)o = acc[ai][0][m][0]; *(f32x4*)(o + 4) = acc[ai][0][m][1]; *(f32x4*)(o + HALF) = acc[ai][1][m][0]; *(f32x4*)(o + HALF + 4) = acc[ai][1][m][1]; }
                    if (!samp) { const int b = row >> 11, t = row & 2047;
                        bf16_t* p = HP + ((size_t)(b * 4 + head0) * SEQ + t) * HD + cb;
                        *(u32x4*)p = pack8(acc[ai][0][m][0], acc[ai][0][m][1]); *(u32x4*)(p + (size_t)SEQ * HD) = pack8(acc[ai][1][m][0], acc[ai][1][m][1]); }
                    else if (kind == 0) { const int r = row - MP, b = r >> 2, t = r & 3;
                        bf16_t* p = QFS + ((size_t)(b * 4 + head0) * DEC_SEQ + t) * HD + cb;
                        *(u32x4*)p = pack8(acc[ai][0][m][0], acc[ai][0][m][1]); *(u32x4*)(p + DEC_SEQ * HD) = pack8(acc[ai][1][m][0], acc[ai][1][m][1]); }
                    asm volatile("" ::: "memory");
                }
        }
    }
};
struct EpiOut {
    static constexpr bool PERM = true, AFTER_DRAIN = false;
    const float* xp; const float* xs; float* YPRE; float* PART;
    __device__ __forceinline__ void operator()(const f32x4 (&acc)[2][2][4][2], const Unit& u, int wr, int wc, int fr, int fq) const {
#pragma unroll
        for (int ai = 0; ai < 2; ++ai)
#pragma unroll
            for (int m = 0; m < 4; ++m) {
                const int row = u.pm * BM + ai * HALF + wr * 64 + m * 16 + fr;
                const float* xr = xrow(xp, xs, row); float ss = 0.f;
#pragma unroll
                for (int bj = 0; bj < 2; ++bj) {
                    const int c0 = u.pn * BM + bj * HALF + wc * 32 + 8 * fq;
                    const f32x4 y0 = acc[ai][bj][m][0] + *(const f32x4*)(xr + c0), y1 = acc[ai][bj][m][1] + *(const f32x4*)(xr + c0 + 4);
                    *(f32x4*)(YPRE + (size_t)row * D_MODEL + c0) = y0; *(f32x4*)(YPRE + (size_t)row * D_MODEL + c0 + 4) = y1;
                    ss += (y0[0] * y0[0] + y0[1] * y0[1]) + (y0[2] * y0[2] + y0[3] * y0[3]) + (y1[0] * y1[0] + y1[1] * y1[1]) + (y1[2] * y1[2] + y1[3] * y1[3]);
                }
                ss += __shfl_xor(ss, 16); ss += __shfl_xor(ss, 32);
                if (fq == 0) PART[(size_t)row * 16 + u.pn * 4 + wc] = ss;
            }
    }
};

template <class Epi, class Sched, bool STAMP = false>
__device__ __forceinline__ void gemm_phase(PG8_LAS unsigned char* lds, const Gemm g, const Sched& S, const Epi& E, unsigned long long* stamps) {
    const int tid = threadIdx.x, wid = __builtin_amdgcn_readfirstlane(tid >> 6), lane = tid & 63, wr = wid >> 2, wc = wid & 3, fr = lane & 15, fq = lane >> 4;
    const int K = g.K, nt = K / BK;
    int ts_lo = 0, ts_hi = 0, nts = 0; const unsigned long long rt_entry = STAMP ? (unsigned long long)wall_clock64() : 0ull;
#define PG8_STAMP() do { if (STAMP && wid == 0 && nts < 64) { const unsigned long long _c = (unsigned long long)clock64(); \
        ts_lo = (lane == nts) ? (int)(unsigned)_c : ts_lo; ts_hi = (lane == nts) ? (int)(unsigned)(_c >> 32) : ts_hi; ++nts; } } while (0)
    PG8_STAMP();
    unsigned voffA[2], voffB[2];
#pragma unroll
    for (int i = 0; i < 2; ++i) { int R, C; stage_rc(tid * 16 + i * 8192, R, C); const int Rb = Epi::PERM ? ((R & ~31) + perm32(R & 31)) : R;
        voffA[i] = (unsigned)(R * K + C) * 2u; voffB[i] = (unsigned)(Rb * K + C) * 2u; }
    const size_t kstep = (size_t)(BK * 2);
    const size_t hstep = (size_t)HALF * K * 2;
    const size_t tstep = 2 * hstep;
    const unsigned ldsw = (unsigned)wid * 1024u;
    const int aoff = lds_byte(wr * 64 + fr, fq * 8), boff = lds_byte(wc * 32 + fr, fq * 8);
#define PG8_SA(b, h) (((b) * 2 + (h)) * HTB)
#define PG8_SB(b, h) ((4 + (b) * 2 + (h)) * HTB)
#define PG8_STAGE(bufoff, gbase, voff) do { _Pragma("unroll") for (int _i = 0; _i < 2; ++_i) \
        __builtin_amdgcn_global_load_lds((const unsigned*)((const char*)(gbase) + (voff)[_i]), (PG8_LAS unsigned*)(lds + (bufoff) + ldsw + _i * 8192), 16, 0, 0); } while (0)
#define PG8_LDA(dst, b, h) do { _Pragma("unroll") for (int m = 0; m < 4; ++m) _Pragma("unroll") for (int k = 0; k < 2; ++k) dst[m][k] = *(const PG8_LAS bf16x8*)(lds + PG8_SA(b, h) + aoff + m * 2048 + k * 1024); } while (0)
#define PG8_LDB(dst, b, h) do { _Pragma("unroll") for (int n = 0; n < 2; ++n) _Pragma("unroll") for (int k = 0; k < 2; ++k) dst[n][k] = *(const PG8_LAS bf16x8*)(lds + PG8_SB(b, h) + boff + n * 2048 + k * 1024); } while (0)
#define PG8_MMA(ai, bj, At, Bt) do { __builtin_amdgcn_s_setprio(1); _Pragma("unroll") for (int m = 0; m < 4; ++m) _Pragma("unroll") for (int n = 0; n < 2; ++n) _Pragma("unroll") for (int k = 0; k < 2; ++k) \
        acc[ai][bj][m][n] = __builtin_amdgcn_mfma_f32_16x16x32_bf16(Bt[n][k], At[m][k], acc[ai][bj][m][n], 0, 0, 0); __builtin_amdgcn_s_setprio(0); } while (0)
#define PG8_WAIT_V(n) asm volatile("s_waitcnt vmcnt(" #n ")" ::: "memory")
#define PG8_WAIT_L(n) asm volatile("s_waitcnt lgkmcnt(" #n ")" ::: "memory")
#define PG8_BAR __builtin_amdgcn_s_barrier()
#define PG8_SCHED __builtin_amdgcn_sched_barrier(0)
    Unit cur, nxt; int ui = 0;
    if (!S.next(0, cur)) return;
    f32x4 acc[2][2][4][2];
#pragma unroll
    for (int a = 0; a < 2; ++a)
#pragma unroll
        for (int b = 0; b < 2; ++b)
#pragma unroll
            for (int m = 0; m < 4; ++m)
#pragma unroll
                for (int n = 0; n < 2; ++n) acc[a][b][m][n] = (f32x4){0.f, 0.f, 0.f, 0.f};
    bf16x8 At[4][2], B0[2][2], B1[2][2];
    const char* cA = (const char*)g.A + (size_t)cur.pm * tstep; const char* cB = (const char*)g.Bt + (size_t)cur.pn * tstep;
    S.a_ready(cur);
    PG8_STAGE(PG8_SB(0, 0), cB, voffB); PG8_STAGE(PG8_SA(0, 0), cA, voffA); PG8_STAGE(PG8_SB(0, 1), cB + hstep, voffB); PG8_STAGE(PG8_SA(0, 1), cA + hstep, voffA);
    if (wr == 1) PG8_BAR;
    PG8_WAIT_V(4); PG8_BAR;
    PG8_STAGE(PG8_SB(1, 0), cB + kstep, voffB); PG8_STAGE(PG8_SA(1, 0), cA + kstep, voffA); PG8_STAGE(PG8_SB(1, 1), cB + hstep + kstep, voffB);
    PG8_WAIT_V(6); PG8_BAR;
    PG8_STAMP();
    for (;;) {
        const bool has_next = S.next(ui + 1, nxt);
        const char* nA = has_next ? (const char*)g.A + (size_t)nxt.pm * tstep : cA; const char* nB = has_next ? (const char*)g.Bt + (size_t)nxt.pn * tstep : cB;
        for (int t = 0; t < nt; t += 2) {
            const bool last = (t == nt - 2);
            const char* a1 = cA + (size_t)(t + 1) * kstep;
            const char* a2 = last ? nA : cA + (size_t)(t + 2) * kstep; const char* b2 = last ? nB : cB + (size_t)(t + 2) * kstep;
            const char* a3 = a2 + kstep; const char* b3 = b2 + kstep;
            if (last && has_next) S.a_ready(nxt);
            PG8_LDB(B0, 0, 0); PG8_SCHED; PG8_LDA(At, 0, 0); PG8_STAGE(PG8_SA(1, 1), a1 + hstep, voffA);
            PG8_WAIT_L(8); PG8_BAR; PG8_WAIT_L(0); PG8_MMA(0, 0, At, B0); PG8_BAR; PG8_SCHED;
            PG8_LDB(B1, 0, 1); PG8_STAGE(PG8_SB(0, 0), b2, voffB);
            PG8_BAR; PG8_WAIT_L(0); PG8_MMA(0, 1, At, B1); PG8_BAR;
            PG8_LDA(At, 0, 1); PG8_STAGE(PG8_SA(0, 0), a2, voffA);
            PG8_BAR; PG8_WAIT_L(0); PG8_MMA(1, 0, At, B0); PG8_BAR; PG8_SCHED;
            PG8_STAGE(PG8_SB(0, 1), b2 + hstep, voffB);
            PG8_WAIT_V(6); PG8_BAR; PG8_MMA(1, 1, At, B1); PG8_BAR;
            PG8_LDB(B0, 1, 0); PG8_SCHED; PG8_LDA(At, 1, 0); PG8_STAGE(PG8_SA(0, 1), a2 + hstep, voffA);
            PG8_WAIT_L(8); PG8_BAR; PG8_WAIT_L(0); PG8_MMA(0, 0, At, B0); PG8_BAR; PG8_SCHED;
            PG8_LDB(B1, 1, 1); PG8_STAGE(PG8_SB(1, 0), b3, voffB);
            PG8_BAR; PG8_WAIT_L(0); PG8_MMA(0, 1, At, B1); PG8_BAR;
            PG8_LDA(At, 1, 1); PG8_STAGE(PG8_SA(1, 0), a3, voffA);
            PG8_BAR; PG8_WAIT_L(0); PG8_MMA(1, 0, At, B0); PG8_BAR; PG8_SCHED;
            PG8_STAGE(PG8_SB(1, 1), b3 + hstep, voffB);
            PG8_WAIT_V(6); PG8_BAR; PG8_MMA(1, 1, At, B1); PG8_BAR;
        }
        PG8_STAMP();
        if constexpr (!Epi::AFTER_DRAIN) { E(acc, cur, wr, wc, fr, fq); S.done(cur); }
        PG8_STAMP();
        if (!has_next) break;
#pragma unroll
        for (int a = 0; a < 2; ++a)
#pragma unroll
            for (int b = 0; b < 2; ++b)
#pragma unroll
                for (int m = 0; m < 4; ++m)
#pragma unroll
                    for (int n = 0; n < 2; ++n) acc[a][b][m][n] = (f32x4){0.f, 0.f, 0.f, 0.f};
        cur = nxt; cA = nA; cB = nB; ++ui;
    }
    PG8_WAIT_V(0);
    if (wr == 0) PG8_BAR;
    PG8_BAR;
    if constexpr (Epi::AFTER_DRAIN) { E.fused(acc, cur, wr, wc, fr, fq, lds, wid, lane); S.done(cur); }
    PG8_STAMP();
    if (STAMP && wid == 0) { stamps[lane] = lane < nts ? (((unsigned long long)(unsigned)ts_hi << 32) | (unsigned)ts_lo) : 0ull;
        if (lane == 62) stamps[62] = rt_entry; if (lane == 63) stamps[63] = (unsigned long long)wall_clock64(); }
#undef PG8_STAMP
#undef PG8_SA
#undef PG8_SB
#undef PG8_STAGE
#undef PG8_LDA
#undef PG8_LDB
#undef PG8_MMA
#undef PG8_WAIT_V
#undef PG8_WAIT_L
#undef PG8_BAR
#undef PG8_SCHED
}
}

namespace fa {
constexpr float SCALE = 0.08838834764831845f;
constexpr int D = 128, NW = 8, QBLK = 32, KVBLK = 64, QB = NW * QBLK;
constexpr int SHM_V = KVBLK * D * 2, SHM_K = KVBLK * D * 2;
constexpr int LDS_G = 2 * SHM_V + 2 * SHM_K + NW * 64 * 4;
constexpr int LDS_BYTES = LDS_G + 2048 * 4;
constexpr float THR2 = 11.5f;
typedef short bf16x8 __attribute__((ext_vector_type(8)));
typedef short s16x4 __attribute__((ext_vector_type(4)));
typedef float f32x16 __attribute__((ext_vector_type(16)));
typedef float f32x4 __attribute__((ext_vector_type(4)));
typedef unsigned u32x4 __attribute__((ext_vector_type(4)));
#define KSWZ(row, colB) ((row) * 256 + ((colB) ^ (((row) & 7) << 4)))
#define SBAR() __builtin_amdgcn_sched_barrier(0)
__device__ __forceinline__ int v_st(int k, int c) { const int kk = (k & ~0xC) | ((k & 4) << 1) | ((k & 8) >> 1); return ((kk >> 3) * 4 + (c >> 5)) * 512 + ((kk & 7) * 32 + (c & 31)) * 2; }
__device__ __forceinline__ int v_rd_base(int lane) { return ((lane & 3) << 3) | (((lane >> 2) & 3) << 6) | (((lane >> 4) & 1) << 5) | (((lane >> 5) & 1) << 8); }
constexpr int v_rd_off(int d0, int ks, int half) { return d0 * 512 + ks * 4096 + half * 2048; }
__device__ __forceinline__ int crow(int r, int hi) { return (r & 3) + 8 * (r >> 2) + 4 * hi; }
__device__ __forceinline__ unsigned cvtpk(float lo, float hi) { unsigned r; asm volatile("v_cvt_pk_bf16_f32 %0, %1, %2" : "=v"(r) : "v"(lo), "v"(hi)); return r; }
__device__ __forceinline__ bf16x8 load8(const bf16_t* p) { return *reinterpret_cast<const bf16x8*>(p); }
__device__ __forceinline__ void mask_tile(f32x16& p0, f32x16& p1, int dq, unsigned W) {
    const float NEG = -__builtin_inff();
#pragma unroll
    for (int r = 0; r < 16; ++r) {
        const int c = (r & 3) + 8 * (r >> 2);
        if ((unsigned)(dq - c) >= W) p0[r] = NEG;
        if ((unsigned)(dq - c - 32) >= W) p1[r] = NEG;
    }
}
__device__ __forceinline__ void partialSM(f32x16& p0, f32x16& p1, float& m_reg, float& mn, float& alpha, const LAS float* gk) {
    constexpr float C2 = 1.4426950408889634f * SCALE;
#pragma unroll
    for (int a4 = 0; a4 < 4; ++a4) { const f32x4 g0 = *(const LAS f32x4*)(gk + 8 * a4), g1 = *(const LAS f32x4*)(gk + 32 + 8 * a4);
#pragma unroll
        for (int b = 0; b < 4; ++b) { p0[4 * a4 + b] = fmaf(p0[4 * a4 + b], C2, g0[b]); p1[4 * a4 + b] = fmaf(p1[4 * a4 + b], C2, g1[b]); } }
    float pmax = p0[0]; for (int r = 1; r < 16; ++r) pmax = fmaxf(pmax, p0[r]); for (int r = 0; r < 16; ++r) pmax = fmaxf(pmax, p1[r]);
    { auto rr = __builtin_amdgcn_permlane32_swap(__float_as_uint(pmax), __float_as_uint(pmax), false, false);
      pmax = fmaxf(__uint_as_float(rr[0]), __uint_as_float(rr[1])); }
    if (__builtin_expect(__all(pmax - m_reg <= THR2), 1)) { mn = m_reg; alpha = 1.f; }
    else { mn = fmaxf(m_reg, pmax); alpha = __builtin_amdgcn_exp2f(m_reg - mn); m_reg = mn; }
    for (int r = 0; r < 16; ++r) p0[r] = p0[r] - mn; for (int r = 0; r < 16; ++r) p1[r] = p1[r] - mn;
    for (int r = 0; r < 16; ++r) p0[r] = __builtin_amdgcn_exp2f(p0[r]);
}
__device__ __forceinline__ void finishSM(f32x16& p0, f32x16& p1, float alpha, float& l_reg, bf16x8& pa0, bf16x8& pa1, bf16x8& pa2, bf16x8& pa3) {
    for (int r = 0; r < 16; ++r) p1[r] = __builtin_amdgcn_exp2f(p1[r]);
    float ps = 0; for (int r = 0; r < 16; ++r) ps += p0[r]; for (int r = 0; r < 16; ++r) ps += p1[r];
    { auto rr = __builtin_amdgcn_permlane32_swap(__float_as_uint(ps), __float_as_uint(ps), false, false);
      ps = __uint_as_float(rr[0]) + __uint_as_float(rr[1]); }
    l_reg = l_reg * alpha + ps;
#define PK4(P, B_, OUT) do { unsigned a0 = cvtpk(P[B_+0], P[B_+1]), a1 = cvtpk(P[B_+2], P[B_+3]);                          \
        unsigned b0 = cvtpk(P[B_+4], P[B_+5]), b1 = cvtpk(P[B_+6], P[B_+7]);                                             \
        auto r0 = __builtin_amdgcn_permlane32_swap(a0, b0, false, false); auto r1 = __builtin_amdgcn_permlane32_swap(a1, b1, false, false); \
        u32x4 w = {r0[0], r1[0], r0[1], r1[1]}; OUT = *reinterpret_cast<bf16x8*>(&w); } while (0)
    PK4(p0, 0, pa0); PK4(p0, 8, pa1); PK4(p1, 0, pa2); PK4(p1, 8, pa3);
#undef PK4
}
template <int KB>
__device__ __forceinline__ void qkt(f32x16& p0, f32x16& p1, const char* K_lds, int r32, int hi, const bf16x8* qr) {
    p0 = f32x16{}; p1 = f32x16{};
    const char* kb[4];
#pragma unroll
    for (int dd = 0; dd < 4; ++dd) kb[dd] = K_lds + KB * SHM_K + KSWZ(r32, (dd * 16 + hi * 8) * 2);
#pragma unroll
    for (int d0 = 0; d0 < 8; ++d0) { const char* a = kb[d0 & 3] + (d0 >> 2) * 128;
        bf16x8 b0 = *reinterpret_cast<const bf16x8*>(a);
        bf16x8 b1 = *reinterpret_cast<const bf16x8*>(a + 32 * 256);
        p0 = __builtin_amdgcn_mfma_f32_32x32x16_bf16(b0, qr[d0], p0, 0, 0, 0);
        p1 = __builtin_amdgcn_mfma_f32_32x32x16_bf16(b1, qr[d0], p1, 0, 0, 0); }
}
template <int VB>
__device__ __forceinline__ void pv_tile(f32x16* o, int vb0, bf16x8 pa0, bf16x8 pa1, bf16x8 pa2, bf16x8 pa3) {
#define TRRD(dst, off) asm volatile("ds_read_b64_tr_b16 %0, %1 offset:%2" : "=&v"(dst) : "v"(vb0), "i"(off) : "memory")
#define PV_D0(d0) do { s16x4 l0, l1, l2, l3, h0, h1, h2, h3; constexpr int b_ = VB * SHM_V + v_rd_off(d0, 0, 0); \
        TRRD(l0, b_); TRRD(h0, b_ + 2048); TRRD(l1, b_ + 4096); TRRD(h1, b_ + 6144); TRRD(l2, b_ + 8192); TRRD(h2, b_ + 10240); TRRD(l3, b_ + 12288); TRRD(h3, b_ + 14336); \
        asm volatile("s_waitcnt lgkmcnt(0)" ::: "memory"); SBAR();   \
        o[d0] = __builtin_amdgcn_mfma_f32_32x32x16_bf16(pa0, (bf16x8){l0[0], l0[1], l0[2], l0[3], h0[0], h0[1], h0[2], h0[3]}, o[d0], 0, 0, 0);   \
        o[d0] = __builtin_amdgcn_mfma_f32_32x32x16_bf16(pa1, (bf16x8){l1[0], l1[1], l1[2], l1[3], h1[0], h1[1], h1[2], h1[3]}, o[d0], 0, 0, 0);   \
        o[d0] = __builtin_amdgcn_mfma_f32_32x32x16_bf16(pa2, (bf16x8){l2[0], l2[1], l2[2], l2[3], h2[0], h2[1], h2[2], h2[3]}, o[d0], 0, 0, 0);   \
        o[d0] = __builtin_amdgcn_mfma_f32_32x32x16_bf16(pa3, (bf16x8){l3[0], l3[1], l3[2], l3[3], h3[0], h3[1], h3[2], h3[3]}, o[d0], 0, 0, 0); } while (0)
    PV_D0(0); PV_D0(1); PV_D0(2); PV_D0(3);
#undef PV_D0
#undef TRRD
}
struct BlockRef { const bf16_t* Q; const bf16_t* K; const bf16_t* V; bf16_t* O; const bf16_t* Z; int P0; };
struct Seam { bf16x8 qr[8]; bf16x8 st_v0, st_v1, st_k0, st_k1; };
#define ROW(p, k0, rr) ((const bf16_t*)((const char*)(p) + (unsigned)((((k0) + (rr)) * D + sc) * 2)))
#define VMW() asm volatile("s_waitcnt vmcnt(0)" ::: "memory")
#define VMWN(n) asm volatile("s_waitcnt vmcnt(%0)" :: "i"(n) : "memory")
#define SLOAD_H(Kp, Vp, k0) do { S.st_v0 = load8(ROW(Vp, k0, sr)); S.st_v1 = load8(ROW(Vp, k0, 32 + sr));              \
                         S.st_k0 = load8(ROW(Kp, k0, sr)); S.st_k1 = load8(ROW(Kp, k0, 32 + sr)); } while (0)
#define SWRITE_HK(bf) do { *(bf16x8*)(K_lds + (bf) * SHM_K + kws) = S.st_k0; *(bf16x8*)(K_lds + (bf) * SHM_K + kws + 32 * 256) = S.st_k1; } while (0)
#define SWRITE_HV(bf) do { *(bf16x8*)(V_lds + (bf) * SHM_V + vst0) = S.st_v0; *(bf16x8*)(V_lds + (bf) * SHM_V + vst1) = S.st_v1; } while (0)
#define SWRITE_H(bf) do { SWRITE_HV(bf); SWRITE_HK(bf); } while (0)
__device__ __forceinline__ void fox_prime(const BlockRef& cur, const float* Gsrc, char* lds, Seam& S) {
    const int tid = threadIdx.x, wid = __builtin_amdgcn_readfirstlane(tid >> 6), lane = tid & 63, r32 = lane & 31, hi = lane >> 5;
    const int sr = tid >> 4, sc = (tid & 15) * 8, kws = KSWZ(sr, sc * 2); char* K_lds = lds + 2 * SHM_V;
    *(f32x4*)(lds + LDS_G + tid * 16) = *(const f32x4*)(Gsrc + tid * 4);
    for (int d0 = 0; d0 < 8; ++d0) S.qr[d0] = load8((const bf16_t*)((const char*)cur.Q + (unsigned)(((wid * QBLK + r32) * D + d0 * 16 + hi * 8) * 2)));
    SLOAD_H(cur.K, cur.V, 0); VMW(); SWRITE_HK(0);
    __syncthreads();
}
__device__ __forceinline__ void fox_block(const BlockRef& cur, const BlockRef& nxt, char* lds, Seam& S) {
    constexpr int W = 1 << 30;
    const int tid = threadIdx.x, wid = __builtin_amdgcn_readfirstlane(tid >> 6), lane = tid & 63, r32 = lane & 31, hi = lane >> 5;
    const int NT = (cur.P0 + QB - 1) / KVBLK + 1;
    const int qlo = cur.P0 + wid * QBLK, qm = qlo + r32 - 4 * hi;
    char* V_lds = lds; char* K_lds = lds + 2 * SHM_V;
    float* ws = (float*)(lds + 2 * SHM_V + 2 * SHM_K) + wid * 64; float* li_l = ws, * al_l = ws + 32;
    const LAS float* Gl = (const LAS float*)(unsigned)(uintptr_t)(lds + LDS_G) + 4 * hi;
    float m_reg = -1e30f, l_reg = 0; f32x16 o[4] = {};
    const int sr = tid >> 4, sc = (tid & 15) * 8, vst0 = v_st(sr, sc), vst1 = v_st(32 + sr, sc), kws = KSWZ(sr, sc * 2);
    const int vb0 = (int)(uintptr_t)V_lds + v_rd_base(lane);
    const bf16_t* Kh = cur.K; const bf16_t* Vh = cur.V;
#define RESC(a) do { if (__any((a) < 1.f)) { if (hi == 0) al_l[r32] = (a); asm volatile("s_waitcnt lgkmcnt(0)" ::: "memory");              \
                     for (int d_ = 0; d_ < 4; ++d_) for (int r = 0; r < 16; ++r) o[d_][r] *= al_l[crow(r, hi)]; } } while (0)
#define KBASE(t) ((t) * KVBLK)
#define MASKT(P0_, P1_, t) do { const int kb_ = KBASE(t); if (kb_ + KVBLK - 1 > qlo) mask_tile(P0_, P1_, qm - kb_, (unsigned)W); } while (0)
    constexpr int NQL = 8;
#define SEAM_K0() do { VMWN(NQL); SWRITE_HK(0); SBAR(); } while (0)
    f32x16 pA0, pA1, pB0, pB1; float mnA, mnB, alA, alB; bf16x8 pa0, pa1, pa2, pa3;
    SWRITE_HV(0); SBAR();
    if (NT > 1) { SLOAD_H(Kh, Vh, KBASE(1)); }
    SBAR(); qkt<0>(pA0, pA1, K_lds, r32, hi, S.qr);
    MASKT(pA0, pA1, 0); partialSM(pA0, pA1, m_reg, mnA, alA, Gl + KBASE(0));
    if (NT > 1) { VMW(); SWRITE_H(1); }
    __syncthreads();
#define HALF_STEP(PX0, PX1, mnX, alX, PY0, PY1, alY, t, KB, VB, SB) do {                                                      \
        SBAR(); qkt<KB>(PX0, PX1, K_lds, r32, hi, S.qr);                                                        \
        finishSM(PY0, PY1, alY, l_reg, pa0, pa1, pa2, pa3); SBAR();                                                           \
        if ((t) + 1 < NT) { SLOAD_H(Kh, Vh, KBASE((t) + 1)); SBAR(); }                                                        \
        pv_tile<VB>(o, vb0, pa0, pa1, pa2, pa3); MASKT(PX0, PX1, (t)); partialSM(PX0, PX1, m_reg, mnX, alX, Gl + KBASE(t));    \
        __syncthreads();                                                                                                      \
        if ((t) + 1 < NT) { VMW(); SWRITE_H(SB); }                                                                            \
        RESC(alX); __syncthreads(); } while (0)
    for (int t = 1; t + 1 < NT; t += 2) {
        HALF_STEP(pB0, pB1, mnB, alB, pA0, pA1, alA, t, 1, 0, 0);
        HALF_STEP(pA0, pA1, mnA, alA, pB0, pB1, alB, t + 1, 0, 1, 1);
    }
    const bool even = (NT & 1) == 0;
    if (even) { SBAR(); qkt<1>(pB0, pB1, K_lds, r32, hi, S.qr); SBAR(); }
    SLOAD_H(nxt.K, nxt.V, 0); SBAR();
#pragma unroll
    for (int d0 = 0; d0 < 8; ++d0) S.qr[d0] = load8((const bf16_t*)((const char*)nxt.Q + (unsigned)(((wid * QBLK + r32) * D + d0 * 16 + hi * 8) * 2)));
    SBAR();
    finishSM(pA0, pA1, alA, l_reg, pa0, pa1, pa2, pa3); SBAR();
    pv_tile<0>(o, vb0, pa0, pa1, pa2, pa3);
    if (even) { MASKT(pB0, pB1, NT - 1); partialSM(pB0, pB1, m_reg, mnB, alB, Gl + KBASE(NT - 1)); __syncthreads(); RESC(alB);
        finishSM(pB0, pB1, alB, l_reg, pa0, pa1, pa2, pa3); SBAR(); pv_tile<1>(o, vb0, pa0, pa1, pa2, pa3); }
    SBAR(); SEAM_K0();
    if (hi == 0) li_l[r32] = l_reg; asm volatile("s_waitcnt lgkmcnt(0)" ::: "memory");
    float rli[16];
#pragma unroll
    for (int r = 0; r < 16; ++r) rli[r] = __builtin_amdgcn_rcpf(li_l[crow(r, hi)]);
    bf16_t* Ow = cur.O + (size_t)(wid * QBLK) * 1024; const bf16_t* Zw = cur.Z + (size_t)(wid * QBLK) * 512;
    const unsigned zo = (unsigned)(4 * hi * 512 + r32), oo = (unsigned)(4 * hi * 1024 + r32);
#pragma unroll
    for (int r = 0; r < 16; ++r) { constexpr int dummy = 0; const int cr = (r & 3) + 8 * (r >> 2);
        float zz[4];
#pragma unroll
        for (int d0 = 0; d0 < 4; ++d0) zz[d0] = bf2f(Zw[zo + (unsigned)(cr * 512 + d0 * 32)]);
#pragma unroll
        for (int d0 = 0; d0 < 4; ++d0) { const float z = zz[d0];
            const float v = o[d0][r] * rli[r] * z * __builtin_amdgcn_rcpf(1.f + __expf(-z));
            const float vn = __shfl_xor(v, 1);
            if ((r32 & 1) == 0) *(unsigned*)(Ow + oo + (unsigned)(cr * 1024 + d0 * 32)) = cvtpk(v, vn); }
        asm volatile("" ::: "memory"); }
    __syncthreads();
#undef RESC
#undef KBASE
#undef MASKT
#undef SEAM_K0
#undef HALF_STEP
}
#undef ROW
#undef VMW
#undef VMWN
#undef SLOAD_H
#undef SWRITE_HK
#undef SWRITE_HV
#undef SWRITE_H
#undef KSWZ
#undef SBAR
}


namespace dec {
constexpr float C2 = 0.08838834764831845f * 1.4426950408889634f;
typedef __attribute__((ext_vector_type(2))) __bf16 bf16x2;
typedef __attribute__((ext_vector_type(4))) unsigned u32x4;
typedef __attribute__((ext_vector_type(4))) float f32x4;
typedef __attribute__((ext_vector_type(8))) float f32x8;
constexpr int LDS_P = 0, LDS_MRG = 4 * 64, MRG_REC = 4 + 128, LDS_FLOATS = LDS_MRG + 4 * 4 * MRG_REC;
__device__ __forceinline__ float dot2(unsigned k, unsigned q, float acc) { return __builtin_amdgcn_fdot2_f32_bf16(__builtin_bit_cast(bf16x2, k), __builtin_bit_cast(bf16x2, q), acc, false); }
__device__ __forceinline__ unsigned cvtpk(float lo, float hi) { unsigned r; asm volatile("v_cvt_pk_bf16_f32 %0, %1, %2" : "=v"(r) : "v"(lo), "v"(hi)); return r; }
template <int CTRL> __device__ __forceinline__ float dpp(float x) { return __builtin_bit_cast(float, __builtin_amdgcn_mov_dpp(__builtin_bit_cast(int, x), CTRL, 0xf, 0xf, true)); }
constexpr int XOR1 = 0xB1, XOR2 = 0x4E, XOR7 = 0x141, XOR8 = 0x128, ROR4 = 0x124;
__device__ __forceinline__ float xrow16_max(float x) {
    auto s = __builtin_amdgcn_permlane16_swap(__float_as_uint(x), __float_as_uint(x), false, false);
    x = fmaxf(__uint_as_float(s[0]), __uint_as_float(s[1]));
    auto t = __builtin_amdgcn_permlane32_swap(__float_as_uint(x), __float_as_uint(x), false, false);
    return fmaxf(__uint_as_float(t[0]), __uint_as_float(t[1]));
}
__device__ __forceinline__ float xrow16_sum(float x) {
    auto s = __builtin_amdgcn_permlane16_swap(__float_as_uint(x), __float_as_uint(x), false, false);
    x = __uint_as_float(s[0]) + __uint_as_float(s[1]);
    auto t = __builtin_amdgcn_permlane32_swap(__float_as_uint(x), __float_as_uint(x), false, false);
    return __uint_as_float(t[0]) + __uint_as_float(t[1]);
}
__device__ __forceinline__ u32x4 tobf(f32x8 x) { u32x4 w = {cvtpk(x[0], x[1]), cvtpk(x[2], x[3]), cvtpk(x[4], x[5]), cvtpk(x[6], x[7])}; return w; }
__device__ __forceinline__ f32x8 ld8nt(const float* p) { return __builtin_nontemporal_load(reinterpret_cast<const f32x8*>(p)); }

__device__ __forceinline__ void dec_item(const float* cache_k, const float* cache_v, const int* pt_row, const bf16_t* q4  , const float* gpast, const float* gnew  ,
                                         const float* knew  , const float* vnew, const bf16_t* znew  , bf16_t* onew  ,
                                         int h, LAS float* lds, int t8) {
    const int lane = t8 & 63, wave = __builtin_amdgcn_readfirstlane(t8 >> 6), r = lane >> 4, c = lane & 15;
    int btv = 0;
    if (lane < 32) { const int sp = wave + 4 * lane; btv = pt_row[sp >> 3] * 128 + (sp & 7) * 16; }
    u32x4 qpk[4];
#pragma unroll
    for (int g = 0; g < 4; ++g) qpk[g] = *(const u32x4*)(q4 + g * 128 + 8 * c);
    const size_t loff = (size_t)r * 512 + (size_t)h * 128 + 8 * c;
    const int goff = r + 4 * (c >> 2);
#define ISSUE(i_) do { const int tb_ = __builtin_amdgcn_readlane(btv, (i_)); const float* kb_ = cache_k + (size_t)tb_ * 512 + loff; const float* vb_ = cache_v + (size_t)tb_ * 512 + loff; \
    _Pragma("unroll") for (int t_ = 0; t_ < 4; ++t_) { Kn[t_] = ld8nt(kb_ + (size_t)t_ * 4 * 512); Vn[t_] = ld8nt(vb_ + (size_t)t_ * 4 * 512); } \
    gsn = gpast[(wave + 4 * (i_)) * 16 + goff]; } while (0)
    f32x8 Kn[4], Vn[4]; float gsn;
    float m = -INFINITY, l = 0.f, acc[32];
#pragma unroll
    for (int k = 0; k < 32; ++k) acc[k] = 0.f;
    ISSUE(0);
    for (int i = 0; i < 32; ++i) {
        u32x4 Kc[4], Vc[4];
#pragma unroll
        for (int t = 0; t < 4; ++t) { Kc[t] = tobf(Kn[t]); Vc[t] = tobf(Vn[t]); }
        const float gs = gsn;
        if (i + 1 < 32) ISSUE(i + 1);
        float x[16];
#pragma unroll
        for (int t = 0; t < 4; ++t)
#pragma unroll
            for (int g = 0; g < 4; ++g) { float d = 0.f;
#pragma unroll
                for (int k = 0; k < 4; ++k) d = dot2(Kc[t][k], qpk[g][k], d);
                x[t * 4 + g] = d; }
#define TR_STEP(HALF, CTRL, BIT) _Pragma("unroll") for (int hh = 0; hh < (HALF); ++hh) { \
      const float lo_ = x[hh], hi_ = x[hh + (HALF)]; const float t1_ = lo_ + dpp<CTRL>(lo_), t2_ = hi_ + dpp<CTRL>(hi_); \
      x[hh] = (c & (BIT)) ? t2_ : t1_; }
        TR_STEP(8, XOR8, 8) TR_STEP(4, XOR7, 4) TR_STEP(2, XOR2, 2) TR_STEP(1, XOR1, 1)
#undef TR_STEP
        const float sc = fmaf(x[0], C2, gs);
        float pm = sc; pm = fmaxf(pm, dpp<ROR4>(pm)); pm = fmaxf(pm, dpp<XOR8>(pm)); pm = xrow16_max(pm);
        const float mn = fmaxf(m, pm);
        const float alpha = __builtin_amdgcn_exp2f(m - mn), p = __builtin_amdgcn_exp2f(sc - mn);
        l = fmaf(l, alpha, p); m = mn;
#pragma unroll
        for (int q4i = 0; q4i < 4; ++q4i) {
            const float al = q4i == 0 ? dpp<0x00>(alpha) : q4i == 1 ? dpp<0x55>(alpha) : q4i == 2 ? dpp<0xAA>(alpha) : dpp<0xFF>(alpha);
#pragma unroll
            for (int k = 0; k < 8; ++k) acc[q4i * 8 + k] *= al; }
        LAS float* prow = lds + LDS_P + (wave * 4 + r) * 16;
        prow[c] = p;
        asm volatile("s_waitcnt lgkmcnt(0)" ::: "memory");
        f32x4 pr[4];
#pragma unroll
        for (int u = 0; u < 4; ++u) pr[u] = *reinterpret_cast<const LAS f32x4*>(prow + 4 * u);
#pragma unroll
        for (int t = 0; t < 4; ++t) {
            float vf[8];
#pragma unroll
            for (int k = 0; k < 4; ++k) { vf[2 * k] = __builtin_bit_cast(float, Vc[t][k] << 16); vf[2 * k + 1] = __builtin_bit_cast(float, Vc[t][k] & 0xffff0000u); }
#pragma unroll
            for (int g = 0; g < 4; ++g) { const float pg_ = pr[t][g];
#pragma unroll
                for (int k = 0; k < 8; ++k) acc[g * 8 + k] = fmaf(pg_, vf[k], acc[g * 8 + k]); } }
    }
#undef ISSUE
#pragma unroll
    for (int k = 0; k < 32; ++k) acc[k] = xrow16_sum(acc[k]);
    { float t = l; t += dpp<ROR4>(t); t += dpp<XOR8>(t); l = xrow16_sum(t); }
    LAS float* mrg = lds + LDS_MRG;
    if (r == 0) {
#pragma unroll
        for (int g = 0; g < 4; ++g) {
            LAS float* rec = mrg + (wave * 4 + g) * MRG_REC;
#pragma unroll
            for (int k = 0; k < 8; k += 4) *reinterpret_cast<LAS f32x4*>(rec + 4 + 8 * c + k) = f32x4{acc[g * 8 + k], acc[g * 8 + k + 1], acc[g * 8 + k + 2], acc[g * 8 + k + 3]};
            if (c == g) { rec[0] = m; rec[1] = l; } } }
    __syncthreads();
    {
        const int g = wave, d0 = 2 * lane;
        float M = -INFINITY;
#pragma unroll
        for (int w = 0; w < 4; ++w) M = fmaxf(M, mrg[(w * 4 + g) * MRG_REC]);
        float L = 0.f, o0 = 0.f, o1 = 0.f;
#pragma unroll
        for (int w = 0; w < 4; ++w) { const LAS float* rec = mrg + (w * 4 + g) * MRG_REC; const float lw = rec[1];
            const float wt = __builtin_amdgcn_exp2f(rec[0] - M);
            L = fmaf(wt, lw, L); o0 = fmaf(wt, rec[4 + d0], o0); o1 = fmaf(wt, rec[4 + d0 + 1], o1); }
        const float q0 = bf2f(q4[g * 128 + d0]), q1 = bf2f(q4[g * 128 + d0 + 1]);
        for (int j = 0; j <= g; ++j) {
            const float2 kk = *(const float2*)(knew + (size_t)j * 512 + h * 128 + d0), vv = *(const float2*)(vnew + (size_t)j * 512 + h * 128 + d0);
            float d = q0 * kk.x + q1 * kk.y;
#pragma unroll
            for (int o = 1; o < 64; o <<= 1) d += __shfl_xor(d, o);
            const float sc = fmaf(d, C2, gnew[j * 4]);
            const float mn = fmaxf(M, sc), wo = __builtin_amdgcn_exp2f(M - mn), p = __builtin_amdgcn_exp2f(sc - mn);
            L = fmaf(L, wo, p); o0 = fmaf(o0, wo, p * vv.x); o1 = fmaf(o1, wo, p * vv.y); M = mn;
        }
        const float inv = 1.f / L;
        const float z0 = bf2f(znew[(size_t)g * 512 + h * 128 + d0]), z1 = bf2f(znew[(size_t)g * 512 + h * 128 + d0 + 1]);
        *(unsigned*)(onew + (size_t)g * 1024 + 512 + h * 128 + d0) = cvtpk(o0 * inv * (z0 / (1.f + __expf(-z0))), o1 * inv * (z1 / (1.f + __expf(-z1))));
    }
}
}


namespace gdn {
typedef short bf16x8 __attribute__((ext_vector_type(8)));
typedef float f32x4 __attribute__((ext_vector_type(4)));
typedef unsigned u32x4 __attribute__((ext_vector_type(4)));
constexpr int L_QS = 0, L_KS = 17408, L_VS = 34816, L_AM = 51200, L_GC = 67584, L_BT = 67840, L_EG = 68096, L_EK = 68352, L_HALF = 68608;
__device__ __forceinline__ int pos32(int c) { return ((c >> 2) & 3) * 8 + (c >> 4) * 4 + (c & 3); }
typedef __bf16 bf16x2_t __attribute__((ext_vector_type(2)));
typedef float f32x2_t __attribute__((ext_vector_type(2)));
__device__ __forceinline__ unsigned cvtpk(float lo, float hi) { const f32x2_t v = {lo, hi}; return __builtin_bit_cast(unsigned, __builtin_convertvector(v, bf16x2_t)); }
__device__ __forceinline__ bf16x8 pack8(const f32x4 a, const f32x4 b) { u32x4 w = {cvtpk(a[0], a[1]), cvtpk(a[2], a[3]), cvtpk(b[0], b[1]), cvtpk(b[2], b[3])}; return *reinterpret_cast<bf16x8*>(&w); }
__device__ __forceinline__ float bfe(const bf16x8 v, int e) { return __uint_as_float(((unsigned)(unsigned short)v[e]) << 16); }

__device__ __forceinline__ void chunk_item(const bf16_t* QKVG, const float* conv_w, const float* BETA, const float* GG, bf16_t* WN, bf16_t* QD, bf16_t* KDT, bf16_t* QKM, float* UT, float* GL,
                                           int b, int h, int n, LAS unsigned char* L, int t8) {
    const int lane = t8 & 63, w4 = __builtin_amdgcn_readfirstlane(t8 >> 6);
    const int ci = (b * 4 + h) * 32 + n; const int row0 = b * SEQ + n * 64;
    LAS bf16_t* QS = (LAS bf16_t*)(L + L_QS); LAS bf16_t* KS = (LAS bf16_t*)(L + L_KS); LAS bf16_t* VS = (LAS bf16_t*)(L + L_VS);
    LAS float* AM = (LAS float*)(L + L_AM); LAS float* GC = (LAS float*)(L + L_GC); LAS float* BT = (LAS float*)(L + L_BT); LAS float* EG = (LAS float*)(L + L_EG); LAS float* EK = (LAS float*)(L + L_EK);
    {
        const int cg = t8 & 15, tg = t8 >> 4;
#pragma unroll
        for (int sec = 0; sec < 3; ++sec) {
            const int cb = sec * 512 + h * 128 + 8 * cg;
            bf16x8 xr[7];
#pragma unroll
            for (int j = 0; j < 7; ++j) { const int tt = n * 64 + 4 * tg - 3 + j;
                xr[j] = tt >= 0 ? *(const bf16x8*)(QKVG + (size_t)(b * SEQ + tt) * CONV_DIM + cb) : (bf16x8){0, 0, 0, 0, 0, 0, 0, 0}; }
            float w[4][8];
#pragma unroll
            for (int j = 0; j < 4; ++j) { const f32x4 w0 = *(const f32x4*)(conv_w + j * CONV_DIM + cb), w1 = *(const f32x4*)(conv_w + j * CONV_DIM + cb + 4);
                w[j][0] = w0[0]; w[j][1] = w0[1]; w[j][2] = w0[2]; w[j][3] = w0[3]; w[j][4] = w1[0]; w[j][5] = w1[1]; w[j][6] = w1[2]; w[j][7] = w1[3]; }
#pragma unroll
            for (int tk = 0; tk < 4; ++tk) {
                float y[8]; float ss = 0.f;
#pragma unroll
                for (int e = 0; e < 8; ++e) { float acc = 0.f;
#pragma unroll
                    for (int j = 0; j < 4; ++j) acc = fmaf(w[j][e], bfe(xr[tk + j], e), acc);
                    y[e] = acc / (1.f + __expf(-acc)); ss = fmaf(y[e], y[e], ss); }
                if (sec < 2) { ss += __shfl_xor(ss, 1); ss += __shfl_xor(ss, 2); ss += __shfl_xor(ss, 4); ss += __shfl_xor(ss, 8);
                    const float rn = rsqrtf(ss + 1e-6f) * (sec == 0 ? 0.08838834764831845f : 1.f);
#pragma unroll
                    for (int e = 0; e < 8; ++e) y[e] *= rn; }
                const u32x4 pk = {cvtpk(y[0], y[1]), cvtpk(y[2], y[3]), cvtpk(y[4], y[5]), cvtpk(y[6], y[7])};
                const int tok = 4 * tg + tk;
                if (sec == 0) *(LAS u32x4*)(QS + tok * 136 + 8 * cg) = pk; else if (sec == 1) *(LAS u32x4*)(KS + tok * 136 + 8 * cg) = pk; else *(LAS u32x4*)(VS + tok * 128 + 8 * cg) = pk;
            }
        }
    }
    if (w4 == 0) {
        float gc = GG[(size_t)(row0 + lane) * 4 + h];
#pragma unroll
        for (int o = 1; o < 64; o <<= 1) { const float t2 = __shfl_up(gc, o); if (lane >= o) gc += t2; }
        const float gl = __shfl(gc, 63);
        GC[lane] = gc; BT[lane] = BETA[(size_t)(row0 + lane) * 4 + h]; EG[lane] = __expf(gc); EK[lane] = __expf(gl - gc);
        if (lane == 63) GL[(size_t)ci * 32] = __expf(gc);
    }
    __syncthreads();
    {
        const int n16 = lane & 15, g = lane >> 4, mi = w4;
        bf16_t* qkm = QKM + (size_t)ci * 4096;
        for (int nj = 0; nj < 4; ++nj) {
            const int j = 16 * nj + n16; const int jp = 32 * (j >> 5) + pos32(j & 31);
            if (nj <= mi) {
                f32x4 akk = {0.f, 0.f, 0.f, 0.f}, aqk = {0.f, 0.f, 0.f, 0.f};
#pragma unroll
                for (int kk = 0; kk < 4; ++kk) {
                    const bf16x8 ak = *(const LAS bf16x8*)(KS + (16 * mi + n16) * 136 + 32 * kk + 8 * g), aq = *(const LAS bf16x8*)(QS + (16 * mi + n16) * 136 + 32 * kk + 8 * g);
                    const bf16x8 bb = *(const LAS bf16x8*)(KS + (16 * nj + n16) * 136 + 32 * kk + 8 * g);
                    akk = __builtin_amdgcn_mfma_f32_16x16x32_bf16(ak, bb, akk, 0, 0, 0); aqk = __builtin_amdgcn_mfma_f32_16x16x32_bf16(aq, bb, aqk, 0, 0, 0); }
                const float gcj = GC[j];
#pragma unroll
                for (int r = 0; r < 4; ++r) { const int i = 16 * mi + 4 * g + r; const float dec = __expf(fminf(GC[i] - gcj, 0.f));
                    AM[i * 64 + j] = (i > j) ? BT[i] * akk[r] * dec : 0.f;
                    qkm[i * 64 + jp] = (bf16_t)f2bf((i >= j) ? aqk[r] * dec : 0.f); }
            } else {
#pragma unroll
                for (int r = 0; r < 4; ++r) { const int i = 16 * mi + 4 * g + r; qkm[i * 64 + jp] = 0; }
            }
        }
        { const int tok = t8 >> 2, qt = t8 & 3; const float e = EG[tok]; float q[32];
#pragma unroll
          for (int v = 0; v < 4; ++v) { const bf16x8 x = *(const LAS bf16x8*)(QS + tok * 136 + 32 * qt + 8 * v);
#pragma unroll
              for (int k = 0; k < 8; ++k) q[8 * v + k] = bfe(x, k) * e; }
#pragma unroll
          for (int gg = 0; gg < 4; ++gg) { const u32x4 o = {cvtpk(q[4 * gg], q[4 * gg + 1]), cvtpk(q[4 * gg + 2], q[4 * gg + 3]), cvtpk(q[16 + 4 * gg], q[16 + 4 * gg + 1]), cvtpk(q[16 + 4 * gg + 2], q[16 + 4 * gg + 3])};
              *(u32x4*)(QD + (size_t)ci * 8192 + tok * 128 + 32 * qt + 8 * gg) = o; } }
        { const int dk = t8 & 127, th = t8 >> 7; float kv[32];
#pragma unroll
          for (int c = 0; c < 32; ++c) kv[c] = bf2f(KS[(32 * th + c) * 136 + dk]) * EK[32 * th + c];
#pragma unroll
          for (int gg = 0; gg < 4; ++gg) { const u32x4 o = {cvtpk(kv[4 * gg], kv[4 * gg + 1]), cvtpk(kv[4 * gg + 2], kv[4 * gg + 3]), cvtpk(kv[16 + 4 * gg], kv[16 + 4 * gg + 1]), cvtpk(kv[16 + 4 * gg + 2], kv[16 + 4 * gg + 3])};
              *(u32x4*)(KDT + (size_t)ci * 8192 + dk * 64 + 32 * th + 8 * gg) = o; } }
    }
    __syncthreads();
    {
        const int c = t8; float x[64];
        if (c < 128) {
#pragma unroll
            for (int r = 0; r < 64; ++r) x[r] = BT[r] * bf2f(VS[r * 128 + c]);
        } else {
#pragma unroll
            for (int r = 0; r < 64; ++r) x[r] = BT[r] * EG[r] * bf2f(KS[r * 136 + (c - 128)]);
        }
#pragma unroll
        for (int r = 1; r < 64; ++r) {
#pragma unroll
            for (int k4 = 0; k4 < (r + 3) / 4; ++k4) { const f32x4 a4 = *(const LAS f32x4*)(AM + r * 64 + 4 * k4);
#pragma unroll
                for (int e = 0; e < 4; ++e) if (4 * k4 + e < r) x[r] = fmaf(-a4[e], x[4 * k4 + e], x[r]); }
        }
        if (c < 128) { float* u = UT + (size_t)ci * 8192 + c * 64;
#pragma unroll
            for (int r = 0; r < 64; r += 4) *(f32x4*)(u + r) = (f32x4){x[r], x[r + 1], x[r + 2], x[r + 3]}; }
        else { const int dk = c - 128, dp = 32 * (dk >> 5) + pos32(dk & 31);
#pragma unroll
            for (int r = 0; r < 64; ++r) QS[r * 136 + dp] = (bf16_t)f2bf(-x[r]); }
    }
    __syncthreads();
    {
#pragma unroll
        for (int i = 0; i < 4; ++i) { const int q = i * 256 + t8, row = q >> 4, cc = q & 15;
            *(u32x4*)(WN + (size_t)ci * 8192 + row * 128 + cc * 8) = *(const LAS u32x4*)(QS + row * 136 + cc * 8); }
    }
    __syncthreads();
}

constexpr int S_WN = 0, S_QD = 17408, S_KDT = 34816, S_QKM = 53248, S_OT = 62464, S_BYTES = 62464 + 64 * 132 * 4;
__device__ __forceinline__ void scan_head(const bf16_t* WN, const bf16_t* QD, const bf16_t* KDT, const bf16_t* QKM, const float* UT, const float* GL,
                                          const bf16_t* ZG, const float* onw, bf16_t* OMIX, float* ssm_out, int b, int h, LAS unsigned char* L) {
    const int tid = threadIdx.x, lane = tid & 63, wave = __builtin_amdgcn_readfirstlane(tid >> 6), n16 = lane & 15, g = lane >> 4, dv0 = 16 * wave;
    const int ci0 = (b * 4 + h) * 32;
    LAS float* OT = (LAS float*)(L + S_OT);
    u32x4 st[7];
#define SC_LOAD(nn) do { const size_t cb_ = (size_t)(ci0 + (nn)) * 8192; \
        st[0] = *(const u32x4*)(WN + cb_ + (size_t)tid * 8); st[1] = *(const u32x4*)(WN + cb_ + (size_t)(512 + tid) * 8); \
        st[2] = *(const u32x4*)(QD + cb_ + (size_t)tid * 8); st[3] = *(const u32x4*)(QD + cb_ + (size_t)(512 + tid) * 8); \
        st[4] = *(const u32x4*)(KDT + cb_ + (size_t)tid * 8); st[5] = *(const u32x4*)(KDT + cb_ + (size_t)(512 + tid) * 8); \
        st[6] = *(const u32x4*)(QKM + (size_t)(ci0 + (nn)) * 4096 + (size_t)tid * 8); } while (0)
#define SC_WRITE() do { \
        *(LAS u32x4*)(L + S_WN + (tid >> 4) * 272 + (tid & 15) * 16) = st[0]; *(LAS u32x4*)(L + S_WN + (32 + (tid >> 4)) * 272 + (tid & 15) * 16) = st[1]; \
        *(LAS u32x4*)(L + S_QD + (tid >> 4) * 272 + (tid & 15) * 16) = st[2]; *(LAS u32x4*)(L + S_QD + (32 + (tid >> 4)) * 272 + (tid & 15) * 16) = st[3]; \
        *(LAS u32x4*)(L + S_KDT + (tid >> 3) * 144 + (tid & 7) * 16) = st[4]; *(LAS u32x4*)(L + S_KDT + (64 + (tid >> 3)) * 144 + (tid & 7) * 16) = st[5]; \
        *(LAS u32x4*)(L + S_QKM + (tid >> 3) * 144 + (tid & 7) * 16) = st[6]; } while (0)
    f32x4 Sacc[8];
#pragma unroll
    for (int i = 0; i < 8; ++i) Sacc[i] = (f32x4){0.f, 0.f, 0.f, 0.f};
    SC_LOAD(0); SC_WRITE();
    __syncthreads();
    for (int n = 0; n < 32; ++n) {
        if (n + 1 < 32) SC_LOAD(n + 1);
        bf16x8 bS[4];
#pragma unroll
        for (int kk = 0; kk < 4; ++kk) bS[kk] = pack8(Sacc[2 * kk], Sacc[2 * kk + 1]);
        f32x4 vn[4];
        const float* ut = UT + (size_t)(ci0 + n) * 8192 + (size_t)(dv0 + n16) * 64 + 4 * g;
#pragma unroll
        for (int mt = 0; mt < 4; ++mt) vn[mt] = *(const f32x4*)(ut + 16 * mt);
#pragma unroll
        for (int mt = 0; mt < 4; ++mt)
#pragma unroll
            for (int kk = 0; kk < 4; ++kk) { const bf16x8 a = *(const LAS bf16x8*)(L + S_WN + (16 * mt + n16) * 272 + (32 * kk + 8 * g) * 2);
                vn[mt] = __builtin_amdgcn_mfma_f32_16x16x32_bf16(a, bS[kk], vn[mt], 0, 0, 0); }
        bf16x8 bV[2];
        bV[0] = pack8(vn[0], vn[1]); bV[1] = pack8(vn[2], vn[3]);
        f32x4 o[4];
#pragma unroll
        for (int mt = 0; mt < 4; ++mt) { o[mt] = (f32x4){0.f, 0.f, 0.f, 0.f};
#pragma unroll
            for (int kk = 0; kk < 4; ++kk) { const bf16x8 a = *(const LAS bf16x8*)(L + S_QD + (16 * mt + n16) * 272 + (32 * kk + 8 * g) * 2);
                o[mt] = __builtin_amdgcn_mfma_f32_16x16x32_bf16(a, bS[kk], o[mt], 0, 0, 0); }
#pragma unroll
            for (int k2 = 0; k2 < 2; ++k2) { const bf16x8 a = *(const LAS bf16x8*)(L + S_QKM + (16 * mt + n16) * 144 + (32 * k2 + 8 * g) * 2);
                o[mt] = __builtin_amdgcn_mfma_f32_16x16x32_bf16(a, bV[k2], o[mt], 0, 0, 0); } }
        const float gl = GL[(size_t)(ci0 + n) * 32];
#pragma unroll
        for (int m8 = 0; m8 < 8; ++m8) { Sacc[m8] = Sacc[m8] * gl;
#pragma unroll
            for (int k2 = 0; k2 < 2; ++k2) { const bf16x8 a = *(const LAS bf16x8*)(L + S_KDT + (16 * m8 + n16) * 144 + (32 * k2 + 8 * g) * 2);
                Sacc[m8] = __builtin_amdgcn_mfma_f32_16x16x32_bf16(a, bV[k2], Sacc[m8], 0, 0, 0); } }
#pragma unroll
        for (int mt = 0; mt < 4; ++mt)
#pragma unroll
            for (int r = 0; r < 4; ++r) OT[(16 * mt + 4 * g + r) * 132 + dv0 + n16] = o[mt][r];
        __syncthreads();
        if (n + 1 < 32) SC_WRITE();
#pragma unroll
        for (int tt = 0; tt < 8; ++tt) { const int tok = 8 * wave + tt; const float o0 = OT[tok * 132 + lane], o1 = OT[tok * 132 + lane + 64];
            float ss = o0 * o0 + o1 * o1;
#pragma unroll
            for (int of = 1; of < 64; of <<= 1) ss += __shfl_xor(ss, of);
            const float rr = rsqrtf(ss * (1.f / 128.f) + 1e-6f); const size_t row = (size_t)b * SEQ + n * 64 + tok;
            const float z0 = bf2f(ZG[row * 512 + h * 128 + lane]), z1 = bf2f(ZG[row * 512 + h * 128 + lane + 64]);
            OMIX[row * 1024 + h * 128 + lane] = (bf16_t)f2bf(o0 * rr * onw[lane] * (z0 / (1.f + __expf(-z0))));
            OMIX[row * 1024 + h * 128 + lane + 64] = (bf16_t)f2bf(o1 * rr * onw[lane + 64] * (z1 / (1.f + __expf(-z1)))); }
        __syncthreads();
    }
#undef SC_LOAD
#undef SC_WRITE
#pragma unroll
    for (int m8 = 0; m8 < 8; ++m8)
#pragma unroll
        for (int r = 0; r < 4; ++r) ssm_out[(size_t)(16 * m8 + 4 * g + r) * 128 + dv0 + n16] = Sacc[m8][r];
}
}

#define XB_TMO      128
#define XB_XCNT(j)  (256  + 64 * (j))
#define XB_XSUB(j)  (1280 + 64 * (j))
#define XB_XGEN(j)  (2304 + 64 * (j))
#define XB_TOP      3328
#define XB_TOPGEN   3392
#define XCD_BAR_WORDS 3456
#define XB_SPIN_CAP (1u << 24)

__device__ __forceinline__ unsigned xb_ld(unsigned* p)              { return __hip_atomic_load(p, __ATOMIC_RELAXED, __HIP_MEMORY_SCOPE_AGENT); }
__device__ __forceinline__ unsigned xb_add(unsigned* p, unsigned v) { return __hip_atomic_fetch_add(p, v, __ATOMIC_RELAXED, __HIP_MEMORY_SCOPE_AGENT); }
__device__ __forceinline__ unsigned xb_xcc_id() { return (unsigned)__builtin_amdgcn_s_getreg((3 << 11) | 20) & 0xFu; }
#define XB_SPIN(cond, bar) do { unsigned _sp = 0; while (cond) { __builtin_amdgcn_s_sleep(1); \
    if ((++_sp & 255u) == 0u) { if (xb_ld(&(bar)[XB_TMO])) break; if (_sp > XB_SPIN_CAP) { atomicAdd(&(bar)[XB_TMO], 1u); break; } } } } while (0)

struct XcdBarrier {
    unsigned* bar; unsigned x;
    volatile LAS unsigned* st;
};

__device__ __forceinline__ XcdBarrier xcd_barrier_post(unsigned* bar, volatile LAS unsigned* st) {
    XcdBarrier b; b.bar = bar; b.x = xb_xcc_id(); b.st = st;
    if (threadIdx.x == 0) (void)xb_add(&bar[XB_XCNT(b.x)], 1u);
    return b;
}
__device__ __forceinline__ void xcd_barrier_complete(unsigned* bar, unsigned x, unsigned& nloc, unsigned& nx) {
    const unsigned G = gridDim.x * gridDim.y * gridDim.z;
    unsigned sum, cnt, mine, sp = 0u;
    for (;;) {
        sum = 0u; cnt = 0u; mine = 0u;
#pragma unroll
        for (unsigned j = 0; j < 16; ++j) { const unsigned c = xb_ld(&bar[XB_XCNT(j)]); sum += c; cnt += (c > 0u) ? 1u : 0u; mine = (j == x) ? c : mine; }
        if (sum == G) break;
        __builtin_amdgcn_s_sleep(1);
        if ((++sp & 255u) == 0u) { if (xb_ld(&bar[XB_TMO])) break; if (sp > XB_SPIN_CAP) { atomicAdd(&bar[XB_TMO], 1u); break; } }
    }
    nloc = mine > 0u ? mine : 1u; nx = cnt > 0u ? cnt : 1u;
}

__device__ __forceinline__ void xcd_barrier(const XcdBarrier& b) {
    asm volatile("s_waitcnt vmcnt(0)" ::: "memory");
    __syncthreads();
    if (threadIdx.x == 0) {
        unsigned* bar = b.bar;
        __builtin_amdgcn_s_waitcnt(0);
        unsigned nloc = b.st[0], nx = b.st[1];
        if (nloc == 0u) { xcd_barrier_complete(bar, b.x, nloc, nx); b.st[0] = nloc; b.st[1] = nx; }
        const unsigned old = xb_add(&bar[XB_XSUB(b.x)], 1u);
        const unsigned gen = old / nloc;
        if (old + 1u == (gen + 1u) * nloc) {
            __builtin_amdgcn_fence(__ATOMIC_RELEASE, "agent");
            asm volatile("s_waitcnt vmcnt(0)" ::: "memory");
            const unsigned og = xb_add(&bar[XB_TOP], 1u);
            const unsigned tg = og / nx;
            if (og + 1u == (tg + 1u) * nx) xb_add(&bar[XB_TOPGEN], 1u);
            else XB_SPIN(xb_ld(&bar[XB_TOPGEN]) == tg, bar);
            __builtin_amdgcn_fence(__ATOMIC_ACQUIRE, "agent");
            xb_add(&bar[XB_XGEN(b.x)], 1u);
            asm volatile("s_waitcnt vmcnt(0)" ::: "memory");
        } else {
            XB_SPIN(xb_ld(&bar[XB_XGEN(b.x)]) == gen, bar);
            __builtin_amdgcn_fence(__ATOMIC_ACQUIRE, "agent");
            asm volatile("s_waitcnt vmcnt(0)" ::: "memory");
        }
    }
    __syncthreads();
}

constexpr int RING_OFF = 0, RING_BYTES = 137216;
constexpr int LDSCTL_OFF = RING_BYTES, MISC_OFF = LDSCTL_OFF + 320;
constexpr int LDS_BYTES = RING_BYTES + 1024;
constexpr int NWAVES = 8, NTHREADS = 512;
constexpr int CW_BAR = 4096;

typedef unsigned u32x4_t __attribute__((ext_vector_type(4)));
typedef float f32x4_t __attribute__((ext_vector_type(4)));
typedef short bf16x8_t __attribute__((ext_vector_type(8)));

__device__ __forceinline__ void p0_transpose_item(const float* W, int ldw, int K, int col0, int k0, bf16_t* WT, int wt_row0, LAS float* scr, int lane) {
#pragma unroll 8
    for (int i = 0; i < 32; ++i) { const int kk = 2 * i + (lane >> 5); scr[kk * 33 + (lane & 31)] = W[(size_t)(k0 + kk) * ldw + col0 + (lane & 31)]; }
    asm volatile("s_waitcnt lgkmcnt(0)" ::: "memory");
    const int c = lane & 7;
#pragma unroll
    for (int j = 0; j < 4; ++j) { const int n = (lane >> 3) + 8 * j; const LAS float* s = scr + (8 * c) * 33 + n;
        u32x4_t o; o.x = pk2(s[0 * 33], s[1 * 33]); o.y = pk2(s[2 * 33], s[3 * 33]); o.z = pk2(s[4 * 33], s[5 * 33]); o.w = pk2(s[6 * 33], s[7 * 33]);
        *(u32x4_t*)(WT + (size_t)(wt_row0 + n) * K + k0 + 8 * c) = o; }
    asm volatile("s_waitcnt lgkmcnt(0)" ::: "memory");
}
__device__ __forceinline__ float wave_sum(float v) {
#pragma unroll
    for (int o = 1; o < 64; o <<= 1) v += __shfl_xor(v, o);
    return v;
}

struct Args {
    const float* x_prompt; const float* x_sample; const float* cache_k; const float* cache_v; const float* cache_logf; const int* page_table;
    const float* state_ssm; const float* state_conv; const float* w_in; const float* conv_w; const float* a_log; const float* dt_bias;
    const float* onorm_w; const float* f_bias; const float* w_out; const float* norm_w; const float* final_norm_w;
    float* out; unsigned char* ws; int ph_lo, ph_hi;
};

__global__ void __launch_bounds__(NTHREADS, 2) mega(Args a) {
    extern __shared__ __attribute__((aligned(16))) unsigned char lds_raw[];
    LAS unsigned char* lds = (LAS unsigned char*)lds_raw;
    const int tid = threadIdx.x, lane = tid & 63, wave = __builtin_amdgcn_readfirstlane(tid >> 6);
    const int G = gridDim.x, gw = blockIdx.x * NWAVES + wave, NGW = G * NWAVES;
    unsigned char* ws = a.ws;
    for (int u = tid; u < (LDS_BYTES - LDSCTL_OFF) / 4; u += NTHREADS) ((LAS unsigned*)(lds + LDSCTL_OFF))[u] = 0u;
    __syncthreads();
    XcdBarrier bar = xcd_barrier_post((unsigned*)(ws + W_CTL) + CW_BAR, (volatile LAS unsigned*)(lds + MISC_OFF) + 8);
    const int lo = a.ph_lo, hi = a.ph_hi;
#define IN(k) (lo <= (k) && (k) < hi)
#define BOTH(k) (IN(k) && IN((k) + 1))

    if (IN(0)) {
        bf16_t* WINT = (bf16_t*)(ws + W_WINT); bf16_t* WSM = (bf16_t*)(ws + W_WSM); bf16_t* WOUT = (bf16_t*)(ws + W_WOUT); bf16_t* HB = (bf16_t*)(ws + W_HB);
        LAS float* scr = (LAS float*)(lds + RING_OFF + wave * 16384);
        constexpr int I_IN = (D_MODEL / 64) * (4096 / 32), I_OUT = (D_MODEL / 64) * (D_MODEL / 32);
        for (int it = gw; it < I_IN + I_OUT; it += NGW) {
            if (it < I_IN) { const int kb = it / 128, nb = it % 128, n0 = 32 * nb; const int col0 = n0 < 2048 ? n0 : n0 + 8;
                p0_transpose_item(a.w_in, D_IN, D_MODEL, col0, 64 * kb, WINT, n0, scr, lane); }
            else { const int r = it - I_IN, kb = r / 32, nb = r % 32;
                p0_transpose_item(a.w_out, D_MODEL, D_MODEL, 32 * nb, 64 * kb, WOUT, 32 * nb, scr, lane); }
        }
        for (int i = blockIdx.x * NTHREADS + tid; i < 16 * D_MODEL; i += G * NTHREADS) {
            const int n = i >> 10, k = i & 1023; float v = 0.f;
            if (n < 8) v = a.w_in[(size_t)k * D_IN + C_BG + n]; else if (n < 12) v = a.w_in[(size_t)k * D_IN + C_FF + (n - 8)];
            WSM[i] = (bf16_t)f2bf(v);
        }
        for (int m = gw; m < MT; m += NGW) {
            const f32x4_t* xr = (const f32x4_t*)xrow(a.x_prompt, a.x_sample, m) + lane;
            const f32x4_t* wr4 = (const f32x4_t*)a.norm_w + lane;
            f32x4_t v[4]; float s = 0.f;
#pragma unroll
            for (int j = 0; j < 4; ++j) { v[j] = xr[64 * j]; s += (v[j].x * v[j].x + v[j].y * v[j].y) + (v[j].z * v[j].z + v[j].w * v[j].w); }
            const float rstd = rsqrtf(wave_sum(s) * (1.f / D_MODEL) + 1e-6f);
            unsigned long long* o8 = (unsigned long long*)(HB + (size_t)m * D_MODEL) + lane;
#pragma unroll
            for (int j = 0; j < 4; ++j) { const f32x4_t w4 = wr4[64 * j];
                o8[64 * j] = (unsigned long long)pk2(v[j].x * rstd * w4.x, v[j].y * rstd * w4.y) | ((unsigned long long)pk2(v[j].z * rstd * w4.z, v[j].w * rstd * w4.w) << 32); }
        }
        if (BOTH(0)) xcd_barrier(bar);
    }

    if (IN(1)) {
        bf16_t* WINT = (bf16_t*)(ws + W_WINT); bf16_t* WSM = (bf16_t*)(ws + W_WSM); bf16_t* HB = (bf16_t*)(ws + W_HB);
        bf16_t* QKVG = (bf16_t*)(ws + W_QKVG); bf16_t* ZG = (bf16_t*)(ws + W_ZG); bf16_t* ZF = (bf16_t*)(ws + W_ZF);
        bf16_t* QFP = (bf16_t*)(ws + W_QFP); bf16_t* KFP = (bf16_t*)(ws + W_KFP); bf16_t* VFP = (bf16_t*)(ws + W_VFP); bf16_t* QFS = (bf16_t*)(ws + W_QFS);
        float* BETA = (float*)(ws + W_BETA); float* GG = (float*)(ws + W_G); float* LOGF = (float*)(ws + W_LOGF);
        pg8::Gemm g{HB, WINT, MT, 4096, D_MODEL}; pg8::StaticOrder S; S.init(MT, 4096, G, (int)blockIdx.x);
        pg8::EpiProj E{QKVG, ZG, ZF, QFP, KFP, VFP, QFS, a.out};
        pg8::gemm_phase<pg8::EpiProj, pg8::StaticOrder, false>(lds + RING_OFF, g, S, E, nullptr);
        for (int tile = gw; tile < MT / 16; tile += NGW) {
            const int row0 = tile * 16;
            f32x4_t acc = {0.f, 0.f, 0.f, 0.f};
            const bf16_t* ap = HB + (size_t)(row0 + (lane & 15)) * D_MODEL + 8 * (lane >> 4);
            const bf16_t* bp = WSM + (size_t)(lane & 15) * D_MODEL + 8 * (lane >> 4);
#pragma unroll 8
            for (int kk = 0; kk < 32; ++kk) { const bf16x8_t av = *(const bf16x8_t*)(ap + 32 * kk), bv = *(const bf16x8_t*)(bp + 32 * kk);
                acc = __builtin_amdgcn_mfma_f32_16x16x32_bf16(av, bv, acc, 0, 0, 0); }
            const int col = lane & 15;
#pragma unroll
            for (int j = 0; j < 4; ++j) {
                const int row = row0 + 4 * (lane >> 4) + j; const float v = acc[j];
                if (col < 4) BETA[row * 4 + col] = sigmoidf_(v);
                else if (col < 8) GG[row * 4 + (col - 4)] = -expf(a.a_log[col - 4]) * softplusf_(v + a.dt_bias[col - 4]);
                else if (col < 12) { const float lf = logsigmoidf_(v + a.f_bias[col - 8]); LOGF[row * 4 + (col - 8)] = lf;
                    if (row < MP) a.out[O_LP + (size_t)row * 4 + (col - 8)] = lf; else a.out[O_LS + (size_t)(row - MP) * 4 + (col - 8)] = lf; }
            }
        }
        if (BOTH(1)) xcd_barrier(bar);
    }

    if (IN(2)) {
        const bf16_t* QKVG = (const bf16_t*)(ws + W_QKVG);
        const float* LOGF = (const float*)(ws + W_LOGF); float* F = (float*)(ws + W_F); float* FP = (float*)(ws + W_FP); float* GPL = (float*)(ws + W_GPL); float* FPL = (float*)(ws + W_FPL); float* FNL = (float*)(ws + W_FNL);
        for (int ch = gw; ch < BATCH * 4 + DEC_BATCH * 4; ch += NGW) {
            float v[32]; float run = 0.f;
            if (ch < BATCH * 4) { const int b = ch >> 2, h = ch & 3;
#pragma unroll
                for (int i = 0; i < 32; ++i) { run += LOGF[((size_t)b * SEQ + 32 * lane + i) * 4 + h]; v[i] = run; } }
            else { const int c2 = ch - BATCH * 4, b = c2 >> 2, h = c2 & 3; const int pg = a.page_table[b * NPAGES + (lane >> 2)];
#pragma unroll
                for (int i = 0; i < 32; ++i) { run += a.cache_logf[((size_t)pg * PAGE + ((32 * lane + i) & 127)) * 4 + h]; v[i] = run; } }
            float incl = run;
#pragma unroll
            for (int o = 1; o < 64; o <<= 1) { const float t2 = __shfl_up(incl, o); if (lane >= o) incl += t2; }
            const float excl = incl - run;
            if (ch < BATCH * 4) { const int b = ch >> 2, h = ch & 3;
#pragma unroll
                for (int i = 0; i < 32; ++i) { F[((size_t)b * SEQ + 32 * lane + i) * 4 + h] = v[i] + excl; GPL[(size_t)ch * SEQ + 32 * lane + i] = -(v[i] + excl) * 1.4426950408889634f; } }
            else { const int c2 = ch - BATCH * 4, b = c2 >> 2, h = c2 & 3;
                const float ftot = __shfl(incl, 63);
#pragma unroll
                for (int i = 0; i < 32; ++i) { FP[((size_t)b * 4 + h) * PAST + 32 * lane + i] = v[i] + excl; FPL[((size_t)b * 4 + h) * PAST + 32 * lane + i] = (ftot - (v[i] + excl)) * 1.4426950408889634f; }
                if (lane == 63) { float acc = incl; for (int t = 0; t < DEC_SEQ; ++t) { const int row = MP + b * DEC_SEQ + t; acc += LOGF[row * 4 + h]; F[row * 4 + h] = acc; FNL[(row - MP) * 4 + h] = (incl - acc) * 1.4426950408889634f; } } }
        }
        const float* BETA = (const float*)(ws + W_BETA); const float* GG = (const float*)(ws + W_G);
        const int half2 = tid >> 8, t8 = tid & 255;
        {
            const bf16_t* ZG = (const bf16_t*)(ws + W_ZG); bf16_t* OMIX = (bf16_t*)(ws + W_OMIX);
            const int dv = t8 & 127, half = t8 >> 7;
            LAS float* sm = (LAS float*)(lds + RING_OFF) + half2 * 1024;
            LAS float* sq = sm; LAS float* sk = sm + 128; LAS float* sv = sm + 256; LAS float* sp = sm + 384; LAS float* sn = sm + 640;
            for (int it = blockIdx.x * 2 + half2; it < DEC_BATCH * 4; it += 2 * G) {
                const int b = it >> 2, h = it & 3; const int row0 = MP + b * DEC_SEQ;
                float S[64];
                { const float* s0 = a.state_ssm + ((size_t)(b * 4 + h) * 128 + 64 * half) * 128 + dv;
#pragma unroll
                  for (int i8 = 0; i8 < 64; i8 += 8) { const float* pb = s0 + i8 * 128;
#pragma unroll
                      for (int i = 0; i < 8; ++i) S[i8 + i] = pb[i * 128];
                      asm volatile("" ::: "memory"); } }
                for (int t = 0; t < DEC_SEQ; ++t) {
                    const int row = row0 + t;
                    for (int cc = 0; cc < 2; ++cc) { if (half == 1 && cc == 1) break;
                        const int c = half == 0 ? (cc == 0 ? h * 128 + dv : 1024 + h * 128 + dv) : 512 + h * 128 + dv;
                        float y = 0.f;
#pragma unroll
                        for (int j = 0; j < 4; ++j) { const int ts = t - 3 + j;
                            const float xv = ts >= 0 ? bf2f(QKVG[(size_t)(row0 + ts) * CONV_DIM + c]) : a.state_conv[((size_t)b * 3 + (3 + ts)) * CONV_DIM + c];
                            y = fmaf(a.conv_w[j * CONV_DIM + c], xv, y); }
                        y = siluf_(y);
                        if (half == 0) { if (cc == 0) sq[dv] = y; else sv[dv] = y; } else sk[dv] = y; }
                    __syncthreads();
                    if (t8 < 64) { float x = sq[t8] * sq[t8] + sq[t8 + 64] * sq[t8 + 64]; for (int o = 32; o >= 1; o >>= 1) x += __shfl_xor(x, o); if (t8 == 0) sn[0] = rsqrtf(x + 1e-6f) * 0.08838834764831845f; }
                    else if (t8 < 128) { const int l = t8 - 64; float x = sk[l] * sk[l] + sk[l + 64] * sk[l + 64]; for (int o = 32; o >= 1; o >>= 1) x += __shfl_xor(x, o); if (l == 0) sn[1] = rsqrtf(x + 1e-6f); }
                    __syncthreads();
                    const float qs = sn[0], ks = sn[1], al = expf(GG[row * 4 + h]), beta = BETA[row * 4 + h];
                    float p = 0.f;
#pragma unroll
                    for (int i8 = 0; i8 < 64; i8 += 8) {
#pragma unroll
                        for (int i = i8; i < i8 + 8; ++i) { S[i] *= al; p = fmaf(S[i], sk[64 * half + i] * ks, p); }
                        asm volatile("" ::: "memory"); }
                    sp[half * 128 + dv] = p;
                    __syncthreads();
                    const float r = sv[dv] - (sp[dv] + sp[128 + dv]);
                    __syncthreads();
                    float po = 0.f;
#pragma unroll
                    for (int i8 = 0; i8 < 64; i8 += 8) {
#pragma unroll
                        for (int i = i8; i < i8 + 8; ++i) { S[i] = fmaf(beta * (sk[64 * half + i] * ks), r, S[i]); po = fmaf(S[i], sq[64 * half + i] * qs, po); }
                        asm volatile("" ::: "memory"); }
                    sp[half * 128 + dv] = po;
                    __syncthreads();
                    if (t8 < 64) { const float o0 = sp[t8] + sp[128 + t8], o1 = sp[t8 + 64] + sp[128 + t8 + 64];
                        float ss = o0 * o0 + o1 * o1; for (int o = 32; o >= 1; o >>= 1) ss += __shfl_xor(ss, o);
                        const float rr = rsqrtf(ss * (1.f / 128.f) + 1e-6f);
                        const bf16_t* z = ZG + (size_t)row * 512 + h * 128; bf16_t* om = OMIX + (size_t)row * 1024 + h * 128;
                        om[t8] = (bf16_t)f2bf(o0 * rr * a.onorm_w[t8] * siluf_(bf2f(z[t8])));
                        om[t8 + 64] = (bf16_t)f2bf(o1 * rr * a.onorm_w[t8 + 64] * siluf_(bf2f(z[t8 + 64]))); }
                    __syncthreads();
                }
                float* so = a.out + O_SSMS + ((size_t)(b * 4 + h) * 128 + 64 * half) * 128 + dv;
#pragma unroll
                for (int i8 = 0; i8 < 64; i8 += 8) { float* pb = so + i8 * 128;
#pragma unroll
                    for (int i = 0; i < 8; ++i) pb[i * 128] = S[i8 + i];
                    asm volatile("" ::: "memory"); }
            }
        }
        __syncthreads();
        for (int ci = blockIdx.x * 2 + half2; ci < BATCH * 4 * 32; ci += 2 * G)
            gdn::chunk_item(QKVG, a.conv_w, BETA, GG, (bf16_t*)(ws + W_WN), (bf16_t*)(ws + W_QD), (bf16_t*)(ws + W_KDT), (bf16_t*)(ws + W_QKM), (float*)(ws + W_UT), (float*)(ws + W_GL),
                            ci >> 7, (ci >> 5) & 3, ci & 31, lds + RING_OFF + half2 * gdn::L_HALF, t8);
        if (BOTH(2)) xcd_barrier(bar);
    }

    if (IN(3)) {
        bf16_t* OMIX = (bf16_t*)(ws + W_OMIX);
        if (blockIdx.x < 32) {
            const int b = blockIdx.x >> 2, h = blockIdx.x & 3;
            gdn::scan_head((const bf16_t*)(ws + W_WN), (const bf16_t*)(ws + W_QD), (const bf16_t*)(ws + W_KDT), (const bf16_t*)(ws + W_QKM), (const float*)(ws + W_UT), (const float*)(ws + W_GL),
                           (const bf16_t*)(ws + W_ZG), a.onorm_w, OMIX, a.out + O_SSMP + (size_t)blockIdx.x * 128 * 128, b, h, lds + RING_OFF);
        }
        else if (blockIdx.x < 160) {
            const int it = blockIdx.x - 32, bh = it >> 2, x = it & 3, b = bh >> 2, h = bh & 3;
            const bf16_t* Qh = (const bf16_t*)(ws + W_QFP) + (size_t)bh * SEQ * HD; const bf16_t* Kh = (const bf16_t*)(ws + W_KFP) + (size_t)bh * SEQ * HD;
            const bf16_t* Vh = (const bf16_t*)(ws + W_VFP) + (size_t)bh * SEQ * HD;
            const int pA = x * 256, pB = (7 - x) * 256;
            fa::BlockRef A{Qh + (size_t)pA * HD, Kh, Vh, OMIX + ((size_t)b * SEQ + pA) * 1024 + 512 + h * 128, (const bf16_t*)(ws + W_ZF) + ((size_t)b * SEQ + pA) * 512 + h * 128, pA};
            fa::BlockRef B{Qh + (size_t)pB * HD, Kh, Vh, OMIX + ((size_t)b * SEQ + pB) * 1024 + 512 + h * 128, (const bf16_t*)(ws + W_ZF) + ((size_t)b * SEQ + pB) * 512 + h * 128, pB};
            fa::Seam Sm;
            fa::fox_prime(A, (const float*)(ws + W_GPL) + (size_t)bh * SEQ, (char*)lds_raw + RING_OFF, Sm);
            fa::fox_block(A, B, (char*)lds_raw + RING_OFF, Sm);
            fa::fox_block(B, B, (char*)lds_raw + RING_OFF, Sm);
        }
        __syncthreads();
        {
            const int half2 = tid >> 8, t8 = tid & 255;
            LAS float* ldsh = (LAS float*)(lds + RING_OFF) + half2 * dec::LDS_FLOATS;
            for (int it = blockIdx.x * 2 + half2; it < DEC_BATCH * 4; it += 2 * G) {
                const int b = it >> 2, h = it & 3;
                dec::dec_item(a.cache_k, a.cache_v, a.page_table + b * NPAGES, (const bf16_t*)(ws + W_QFS) + (size_t)it * DEC_SEQ * HD,
                              (const float*)(ws + W_FPL) + (size_t)it * PAST, (const float*)(ws + W_FNL) + (size_t)b * DEC_SEQ * 4 + h,
                              a.out + O_KS + (size_t)b * DEC_SEQ * 512, a.out + O_VS + (size_t)b * DEC_SEQ * 512,
                              (const bf16_t*)(ws + W_ZF) + (size_t)(MP + b * DEC_SEQ) * 512, OMIX + (size_t)(MP + b * DEC_SEQ) * 1024, h, ldsh, t8);
                __syncthreads();
            }
        }
        xcd_barrier(bar);
    }

    if (IN(5)) {
        bf16_t* WOUT = (bf16_t*)(ws + W_WOUT); bf16_t* OMIX = (bf16_t*)(ws + W_OMIX); float* YPRE = (float*)(ws + W_YPRE); float* PART = (float*)(ws + W_PART);
        pg8::Gemm g{OMIX, WOUT, MT, D_MODEL, D_MODEL}; pg8::StaticOrder S; S.init(MT, D_MODEL, G, (int)blockIdx.x);
        pg8::EpiOut E{a.x_prompt, a.x_sample, YPRE, PART};
        pg8::gemm_phase<pg8::EpiOut, pg8::StaticOrder, false>(lds + RING_OFF, g, S, E, nullptr);
        if (BOTH(5)) xcd_barrier(bar);
    }

    if (IN(6)) {
        float* YPRE = (float*)(ws + W_YPRE); float* PART = (float*)(ws + W_PART);
        for (int m = gw; m < MT; m += NGW) {
            float p = PART[(size_t)m * 16 + (lane & 15)];
            p += __shfl_xor(p, 1); p += __shfl_xor(p, 2); p += __shfl_xor(p, 4); p += __shfl_xor(p, 8);
            const float rstd = rsqrtf(p * (1.f / D_MODEL) + 1e-6f);
            const f32x4_t* yr = (const f32x4_t*)(YPRE + (size_t)m * D_MODEL) + lane;
            const f32x4_t* wr4 = (const f32x4_t*)a.final_norm_w + lane;
            f32x4_t* o = (f32x4_t*)(m < MP ? a.out + O_YP + (size_t)m * D_MODEL : a.out + O_YS + (size_t)(m - MP) * D_MODEL) + lane;
#pragma unroll
            for (int j = 0; j < 4; ++j) o[64 * j] = yr[64 * j] * rstd * wr4[64 * j];
        }
    }
#undef IN
#undef BOTH
}

extern "C" void kernel_launch(void* const* d_in, const int* in_sizes, int n_in, void* d_out, int out_size, void* d_ws, size_t ws_size, hipStream_t stream) {
    static int grid = 0;
    if (grid == 0) {
        if (n_in != 17 || (size_t)out_size != O_END || ws_size < W_END) { fprintf(stderr, "kernel_launch: unexpected shapes\n"); grid = -1; return; }
        int dev = 0, cus = 0;
        if (hipGetDevice(&dev) != hipSuccess || hipDeviceGetAttribute(&cus, hipDeviceAttributeMultiprocessorCount, dev) != hipSuccess) { grid = -1; return; }
        if (hipFuncSetAttribute((const void*)mega, hipFuncAttributeMaxDynamicSharedMemorySize, LDS_BYTES) != hipSuccess) { fprintf(stderr, "kernel_launch: hipFuncSetAttribute failed\n"); grid = -1; return; }
        int per_cu = 0;
        if (hipOccupancyMaxActiveBlocksPerMultiprocessor(&per_cu, (const void*)mega, NTHREADS, LDS_BYTES) != hipSuccess || per_cu < 1) fprintf(stderr, "kernel_launch: occupancy query says %d\n", per_cu);
        (void)hipGetLastError();
        grid = cus;
    }
    if (grid < 0) return;
    Args a{};
    a.x_prompt = (const float*)d_in[0]; a.x_sample = (const float*)d_in[1]; a.cache_k = (const float*)d_in[2]; a.cache_v = (const float*)d_in[3]; a.cache_logf = (const float*)d_in[4];
    a.page_table = (const int*)d_in[5]; a.state_ssm = (const float*)d_in[6]; a.state_conv = (const float*)d_in[7]; a.w_in = (const float*)d_in[8]; a.conv_w = (const float*)d_in[9];
    a.a_log = (const float*)d_in[10]; a.dt_bias = (const float*)d_in[11]; a.onorm_w = (const float*)d_in[12]; a.f_bias = (const float*)d_in[13]; a.w_out = (const float*)d_in[14];
    a.norm_w = (const float*)d_in[15]; a.final_norm_w = (const float*)d_in[16]; a.out = (float*)d_out; a.ws = (unsigned char*)d_ws;
    unsigned char* ws = (unsigned char*)d_ws;
    (void)hipMemsetAsync(ws + W_CTL, 0, CTL_BYTES, stream);
    auto launch = [&](int lo, int hi) { a.ph_lo = lo; a.ph_hi = hi; hipLaunchKernelGGL(mega, dim3(grid), dim3(NTHREADS), LDS_BYTES, stream, a); };
    launch(0, 7);
}
```

```cpp
#include <hip/hip_runtime.h>
#include <stdint.h>
#include <cstdio>

constexpr int D_MODEL = 1024, BATCH = 8, SEQ = 2048, DEC_BATCH = 128, DEC_SEQ = 4, PAST = 2048, PAGE = 128, NPAGES = 16;
constexpr int HD = 128, NH = 4;
constexpr int CONV_DIM = 1536, D_IN = 4108;
constexpr int MP = BATCH * SEQ, MS = DEC_BATCH * DEC_SEQ, MT = MP + MS;
constexpr int C_QKVG = 0, C_ZG = 1536, C_BG = 2048, C_AG = 2052, C_QF = 2056, C_KF = 2568, C_VF = 3080, C_ZF = 3592, C_FF = 4104;
constexpr size_t O_YP = 0, O_YS = O_YP + (size_t)MP * 1024, O_KP = O_YS + (size_t)MS * 1024, O_VP = O_KP + (size_t)MP * 512,
                 O_LP = O_VP + (size_t)MP * 512, O_SSMP = O_LP + (size_t)MP * 4, O_CONVP = O_SSMP + (size_t)BATCH * 4 * 128 * 128,
                 O_KS = O_CONVP + (size_t)BATCH * 3 * 1536, O_VS = O_KS + (size_t)MS * 512, O_LS = O_VS + (size_t)MS * 512,
                 O_SSMS = O_LS + (size_t)MS * 4, O_CONVS = O_SSMS + (size_t)DEC_BATCH * 4 * 128 * 128, O_END = O_CONVS + (size_t)DEC_BATCH * 3 * 1536;
constexpr size_t MiB = 1u << 20;
constexpr size_t W_CTL = 0, CTL_BYTES = 1 * MiB;
constexpr size_t W_WINT = 2 * MiB;
constexpr size_t W_WSM = W_WINT + 8 * MiB;
constexpr size_t W_WOUT = W_WSM + 1 * MiB;
constexpr size_t W_HB = W_WOUT + 2 * MiB;
constexpr size_t W_QKVG = W_HB + 34 * MiB;
constexpr size_t W_ZG = W_QKVG + 50 * MiB;
constexpr size_t W_ZF = W_ZG + 17 * MiB;
constexpr size_t W_QFP = W_ZF + 17 * MiB;
constexpr size_t W_KFP = W_QFP + 16 * MiB;
constexpr size_t W_VFP = W_KFP + 16 * MiB;
constexpr size_t W_QFS = W_VFP + 16 * MiB;
constexpr size_t W_BETA = W_QFS + 1 * MiB;
constexpr size_t W_G = W_BETA + 1 * MiB;
constexpr size_t W_LOGF = W_G + 1 * MiB;
constexpr size_t W_F = W_LOGF + 1 * MiB;
constexpr size_t W_FP = W_F + 1 * MiB;
constexpr size_t W_GPL = W_FP + 4 * MiB;
constexpr size_t W_FPL = W_GPL + 1 * MiB;
constexpr size_t W_FNL = W_FPL + 4 * MiB;
constexpr size_t W_OMIX = W_FNL + 1 * MiB;
constexpr size_t W_YPRE = W_OMIX + 34 * MiB;
constexpr size_t W_PART = W_YPRE + 67 * MiB;
constexpr size_t W_WN = W_PART + 2 * MiB;
constexpr size_t W_QD = W_WN + 16 * MiB;
constexpr size_t W_KDT = W_QD + 16 * MiB;
constexpr size_t W_QKM = W_KDT + 16 * MiB;
constexpr size_t W_UT = W_QKM + 8 * MiB;
constexpr size_t W_GL = W_UT + 32 * MiB;
constexpr size_t W_DPART = W_GL + 1 * MiB;
constexpr size_t W_END = W_DPART + 5 * MiB;

#define LAS __attribute__((address_space(3)))
typedef unsigned short bf16_t;
__device__ __forceinline__ float sigmoidf_(float x) { return 1.f / (1.f + expf(-x)); }
__device__ __forceinline__ float siluf_(float x) { return x / (1.f + expf(-x)); }
__device__ __forceinline__ float softplusf_(float x) { return fmaxf(x, 0.f) + log1pf(expf(-fabsf(x))); }
__device__ __forceinline__ float logsigmoidf_(float x) { return -softplusf_(-x); }
__device__ __forceinline__ float bf2f(bf16_t b) { return __uint_as_float(((unsigned)b) << 16); }
__device__ __forceinline__ unsigned f2bf(float f) { unsigned u = __float_as_uint(f); return (u + 0x7fffu + ((u >> 16) & 1u)) >> 16; }
__device__ __forceinline__ unsigned pk2(float lo, float hi) { return f2bf(lo) | (f2bf(hi) << 16); }
__device__ __forceinline__ const float* xrow(const float* xp, const float* xs, int row) {
    return row < MP ? xp + (size_t)row * D_MODEL : xs + (size_t)(row - MP) * D_MODEL;
}

namespace pg8 {
#define PG8_LAS __attribute__((address_space(3)))
typedef unsigned short bf16_t;
typedef short bf16x8 __attribute__((ext_vector_type(8)));
typedef float f32x4 __attribute__((ext_vector_type(4)));
typedef unsigned u32x4 __attribute__((ext_vector_type(4)));
constexpr int BM = 256, BK = 64, HALF = 128, HTB = HALF * BK * 2  , STAGE_BYTES = 8 * HTB, NXCD = 8, WGM = 8;

__host__ __device__ __forceinline__ int lds_byte(int r, int c) { const int st = (r >> 4) * 2 + (c >> 5), rr = r & 15, cc = c & 31, ob = rr * 64 + cc * 2; return st * 1024 + (ob ^ (((ob >> 9) & 1) << 5)); }
__host__ __device__ __forceinline__ void stage_rc(int b, int& R, int& C) { const int st = b / 1024, sb = b % 1024, swz = sb ^ (((sb >> 9) & 1) << 5); R = (st >> 1) * 16 + swz / 64; C = (st & 1) * 32 + (swz % 64) / 2; }
__host__ __device__ __forceinline__ int perm32(int rho) { const int n = rho >> 4, i = rho & 15; return 8 * (i >> 2) + 4 * n + (i & 3); }

struct Unit { int pm, pn; };
struct Gemm { const bf16_t* A; const bf16_t* Bt; int M, N, K; };

struct StaticOrder {
    int nM, nN, nwg, G, c;
    __host__ __device__ void init(int M, int N, int G_, int c_) { nM = M / BM; nN = N / BM; nwg = nM * nN; G = G_; c = c_; }
    __host__ __device__ bool next(int i, Unit& u) const {
        const long L = (long)i * G + c; if (L >= nwg) return false;
        int wgid = (int)L; { const int q = nwg / NXCD, r = nwg % NXCD, xcd = wgid % NXCD, off = wgid / NXCD; wgid = (xcd < r ? xcd * (q + 1) : r * (q + 1) + (xcd - r) * q) + off; }
        const int nig = WGM * nN, gid = wgid / nig, fm = gid * WGM, gsz = (nM - fm) < WGM ? (nM - fm) : WGM;
        u.pm = fm + ((wgid % nig) % gsz); u.pn = (wgid % nig) / gsz; return true;
    }
    __device__ __forceinline__ void a_ready(const Unit&) const {}
    __device__ __forceinline__ void done(const Unit&) const {}
};

__device__ __forceinline__ unsigned cvt_pk_bf16(float lo, float hi) { unsigned r; asm volatile("v_cvt_pk_bf16_f32 %0, %1, %2" : "=v"(r) : "v"(lo), "v"(hi)); return r; }
__device__ __forceinline__ u32x4 pack8(const f32x4 v0, const f32x4 v1) { u32x4 w; w.x = cvt_pk_bf16(v0[0], v0[1]); w.y = cvt_pk_bf16(v0[2], v0[3]); w.z = cvt_pk_bf16(v1[0], v1[1]); w.w = cvt_pk_bf16(v1[2], v1[3]); return w; }

struct EpiProj {
    static constexpr bool PERM = true, AFTER_DRAIN = false;
    bf16_t* QKVG; bf16_t* ZG; bf16_t* ZF; bf16_t* QFP; bf16_t* KFP; bf16_t* VFP; bf16_t* QFS; float* out;
    __device__ __forceinline__ void operator()(const f32x4 (&acc)[2][2][4][2], const Unit& u, int wr, int wc, int fr, int fq) const {
        const int pn = u.pn; const bool samp = u.pm >= (MP / 256);
        const int rbase = u.pm * BM + wr * 64 + fr, cb = wc * 32 + 8 * fq;
        if (pn < 6) {
            const int c0 = pn * BM + cb;
#pragma unroll
            for (int ai = 0; ai < 2; ++ai)
#pragma unroll
                for (int m = 0; m < 4; ++m) {
                    const int row = rbase + ai * HALF + m * 16;
                    bf16_t* p = QKVG + (size_t)row * CONV_DIM + c0;
                    *(u32x4*)p = pack8(acc[ai][0][m][0], acc[ai][0][m][1]); *(u32x4*)(p + HALF) = pack8(acc[ai][1][m][0], acc[ai][1][m][1]);
                    int j = -1; size_t cob = 0;
                    if (!samp) { const int t = row & 2047; if (t >= SEQ - 3) { j = t - (SEQ - 3); cob = O_CONVP + (size_t)(row >> 11) * 3 * CONV_DIM; } }
                    else { const int r = row - MP, t = r & 3; if (t >= 1) { j = t - 1; cob = O_CONVS + (size_t)(r >> 2) * 3 * CONV_DIM; } }
                    if (j >= 0) { float* co = out + cob + (size_t)j * CONV_DIM + c0;
                        *(f32x4*)co = acc[ai][0][m][0]; *(f32x4*)(co + 4) = acc[ai][0][m][1]; *(f32x4*)(co + HALF) = acc[ai][1][m][0]; *(f32x4*)(co + HALF + 4) = acc[ai][1][m][1]; }
                    asm volatile("" ::: "memory");
                }
        } else if (pn < 8 || pn >= 14) {
            bf16_t* Z = ZG + (pn < 8 ? (size_t)0 : (size_t)((W_ZF - W_ZG) / 2)); const int c0 = (pn < 8 ? pn - 6 : pn - 14) * BM + cb;
#pragma unroll
            for (int ai = 0; ai < 2; ++ai)
#pragma unroll
                for (int m = 0; m < 4; ++m) {
                    const int row = rbase + ai * HALF + m * 16;
                    bf16_t* p = Z + (size_t)row * 512 + c0;
                    *(u32x4*)p = pack8(acc[ai][0][m][0], acc[ai][0][m][1]); *(u32x4*)(p + HALF) = pack8(acc[ai][1][m][0], acc[ai][1][m][1]);
                    asm volatile("" ::: "memory");
                }
        } else {
            const int kind = (pn - 8) >> 1, head0 = ((pn - 8) & 1) * 2;
            bf16_t* HP = QFP + (size_t)kind * ((W_KFP - W_QFP) / 2);
            const size_t ob = kind == 1 ? (samp ? O_KS : O_KP) : (samp ? O_VS : O_VP);
#pragma unroll
            for (int ai = 0; ai < 2; ++ai)
#pragma unroll
                for (int m = 0; m < 4; ++m) {
                    const int row = rbase + ai * HALF + m * 16;
                    if (kind != 0) { float* o = out + ob + (size_t)(samp ? row - MP : row) * 512 + head0 * HD + cb;
                        *(f32x4*)o = acc[ai][0][m][0]; *(f32x4*)(o + 4) = acc[ai][0][m][1]; *(f32x4*)(o + HALF) = acc[ai][1][m][0]; *(f32x4*)(o + HALF + 4) = acc[ai][1][m][1]; }
                    if (!samp) { const int b = row >> 11, t = row & 2047;
                        bf16_t* p = HP + ((size_t)(b * 4 + head0) * SEQ + t) * HD + cb;
                        *(u32x4*)p = pack8(acc[ai][0][m][0], acc[ai][0][m][1]); *(u32x4*)(p + (size_t)SEQ * HD) = pack8(acc[ai][1][m][0], acc[ai][1][m][1]); }
                    else if (kind == 0) { const int r = row - MP, b = r >> 2, t = r & 3;
                        bf16_t* p = QFS + ((size_t)(b * 4 + head0) * DEC_SEQ + t) * HD + cb;
                        *(u32x4*)p = pack8(acc[ai][0][m][0], acc[ai][0][m][1]); *(u32x4*)(p + DEC_SEQ * HD) = pack8(acc[ai][1][m][0], acc[ai][1][m][1]); }
                    asm volatile("" ::: "memory");
                }
        }
    }
};
struct EpiOut {
    static constexpr bool PERM = true, AFTER_DRAIN = false;
    const float* xp; const float* xs; float* YPRE; float* PART;
    __device__ __forceinline__ void operator()(const f32x4 (&acc)[2][2][4][2], const Unit& u, int wr, int wc, int fr, int fq) const {
#pragma unroll
        for (int ai = 0; ai < 2; ++ai)
#pragma unroll
            for (int m = 0; m < 4; ++m) {
                const int row = u.pm * BM + ai * HALF + wr * 64 + m * 16 + fr;
                const float* xr = xrow(xp, xs, row); float ss = 0.f;
#pragma unroll
                for (int bj = 0; bj < 2; ++bj) {
                    const int c0 = u.pn * BM + bj * HALF + wc * 32 + 8 * fq;
                    const f32x4 y0 = acc[ai][bj][m][0] + *(const f32x4*)(xr + c0), y1 = acc[ai][bj][m][1] + *(const f32x4*)(xr + c0 + 4);
                    *(f32x4*)(YPRE + (size_t)row * D_MODEL + c0) = y0; *(f32x4*)(YPRE + (size_t)row * D_MODEL + c0 + 4) = y1;
                    ss += (y0[0] * y0[0] + y0[1] * y0[1]) + (y0[2] * y0[2] + y0[3] * y0[3]) + (y1[0] * y1[0] + y1[1] * y1[1]) + (y1[2] * y1[2] + y1[3] * y1[3]);
                }
                ss += __shfl_xor(ss, 16); ss += __shfl_xor(ss, 32);
                if (fq == 0) PART[(size_t)row * 16 + u.pn * 4 + wc] = ss;
            }
    }
};

template <class Epi, class Sched, bool STAMP = false>
__device__ __forceinline__ void gemm_phase(PG8_LAS unsigned char* lds, const Gemm g, const Sched& S, const Epi& E, unsigned long long* stamps) {
    const int tid = threadIdx.x, wid = __builtin_amdgcn_readfirstlane(tid >> 6), lane = tid & 63, wr = wid >> 2, wc = wid & 3, fr = lane & 15, fq = lane >> 4;
    const int K = g.K, nt = K / BK;
    int ts_lo = 0, ts_hi = 0, nts = 0; const unsigned long long rt_entry = STAMP ? (unsigned long long)wall_clock64() : 0ull;
#define PG8_STAMP() do { if (STAMP && wid == 0 && nts < 64) { const unsigned long long _c = (unsigned long long)clock64(); \
        ts_lo = (lane == nts) ? (int)(unsigned)_c : ts_lo; ts_hi = (lane == nts) ? (int)(unsigned)(_c >> 32) : ts_hi; ++nts; } } while (0)
    PG8_STAMP();
    unsigned voffA[2], voffB[2];
#pragma unroll
    for (int i = 0; i < 2; ++i) { int R, C; stage_rc(tid * 16 + i * 8192, R, C); const int Rb = Epi::PERM ? ((R & ~31) + perm32(R & 31)) : R;
        voffA[i] = (unsigned)(R * K + C) * 2u; voffB[i] = (unsigned)(Rb * K + C) * 2u; }
    const size_t kstep = (size_t)(BK * 2);
    const size_t hstep = (size_t)HALF * K * 2;
    const size_t tstep = 2 * hstep;
    const unsigned ldsw = (unsigned)wid * 1024u;
    const int aoff = lds_byte(wr * 64 + fr, fq * 8), boff = lds_byte(wc * 32 + fr, fq * 8);
#define PG8_SA(b, h) (((b) * 2 + (h)) * HTB)
#define PG8_SB(b, h) ((4 + (b) * 2 + (h)) * HTB)
#define PG8_STAGE(bufoff, gbase, voff) do { _Pragma("unroll") for (int _i = 0; _i < 2; ++_i) \
        __builtin_amdgcn_global_load_lds((const unsigned*)((const char*)(gbase) + (voff)[_i]), (PG8_LAS unsigned*)(lds + (bufoff) + ldsw + _i * 8192), 16, 0, 0); } while (0)
#define PG8_LDA(dst, b, h) do { _Pragma("unroll") for (int m = 0; m < 4; ++m) _Pragma("unroll") for (int k = 0; k < 2; ++k) dst[m][k] = *(const PG8_LAS bf16x8*)(lds + PG8_SA(b, h) + aoff + m * 2048 + k * 1024); } while (0)
#define PG8_LDB(dst, b, h) do { _Pragma("unroll") for (int n = 0; n < 2; ++n) _Pragma("unroll") for (int k = 0; k < 2; ++k) dst[n][k] = *(const PG8_LAS bf16x8*)(lds + PG8_SB(b, h) + boff + n * 2048 + k * 1024); } while (0)
#define PG8_MMA(ai, bj, At, Bt) do { __builtin_amdgcn_s_setprio(1); _Pragma("unroll") for (int m = 0; m < 4; ++m) _Pragma("unroll") for (int n = 0; n < 2; ++n) _Pragma("unroll") for (int k = 0; k < 2; ++k) \
        acc[ai][bj][m][n] = __builtin_amdgcn_mfma_f32_16x16x32_bf16(Bt[n][k], At[m][k], acc[ai][bj][m][n], 0, 0, 0); __builtin_amdgcn_s_setprio(0); } while (0)
#define PG8_WAIT_V(n) asm volatile("s_waitcnt vmcnt(" #n ")" ::: "memory")
#define PG8_WAIT_L(n) asm volatile("s_waitcnt lgkmcnt(" #n ")" ::: "memory")
#define PG8_BAR __builtin_amdgcn_s_barrier()
#define PG8_SCHED __builtin_amdgcn_sched_barrier(0)
    Unit cur, nxt; int ui = 0;
    if (!S.next(0, cur)) return;
    f32x4 acc[2][2][4][2];
#pragma unroll
    for (int a = 0; a < 2; ++a)
#pragma unroll
        for (int b = 0; b < 2; ++b)
#pragma unroll
            for (int m = 0; m < 4; ++m)
#pragma unroll
                for (int n = 0; n < 2; ++n) acc[a][b][m][n] = (f32x4){0.f, 0.f, 0.f, 0.f};
    bf16x8 At[4][2], B0[2][2], B1[2][2];
    const char* cA = (const char*)g.A + (size_t)cur.pm * tstep; const char* cB = (const char*)g.Bt + (size_t)cur.pn * tstep;
    S.a_ready(cur);
    PG8_STAGE(PG8_SB(0, 0), cB, voffB); PG8_STAGE(PG8_SA(0, 0), cA, voffA); PG8_STAGE(PG8_SB(0, 1), cB + hstep, voffB); PG8_STAGE(PG8_SA(0, 1), cA + hstep, voffA);
    if (wr == 1) PG8_BAR;
    PG8_WAIT_V(4); PG8_BAR;
    PG8_STAGE(PG8_SB(1, 0), cB + kstep, voffB); PG8_STAGE(PG8_SA(1, 0), cA + kstep, voffA); PG8_STAGE(PG8_SB(1, 1), cB + hstep + kstep, voffB);
    PG8_WAIT_V(6); PG8_BAR;
    PG8_STAMP();
    for (;;) {
        const bool has_next = S.next(ui + 1, nxt);
        const char* nA = has_next ? (const char*)g.A + (size_t)nxt.pm * tstep : cA; const char* nB = has_next ? (const char*)g.Bt + (size_t)nxt.pn * tstep : cB;
        for (int t = 0; t < nt; t += 2) {
            const bool last = (t == nt - 2);
            const char* a1 = cA + (size_t)(t + 1) * kstep;
            const char* a2 = last ? nA : cA + (size_t)(t + 2) * kstep; const char* b2 = last ? nB : cB + (size_t)(t + 2) * kstep;
            const char* a3 = a2 + kstep; const char* b3 = b2 + kstep;
            if (last && has_next) S.a_ready(nxt);
            PG8_LDB(B0, 0, 0); PG8_SCHED; PG8_LDA(At, 0, 0); PG8_STAGE(PG8_SA(1, 1), a1 + hstep, voffA);
            PG8_WAIT_L(8); PG8_BAR; PG8_WAIT_L(0); PG8_MMA(0, 0, At, B0); PG8_BAR; PG8_SCHED;
            PG8_LDB(B1, 0, 1); PG8_STAGE(PG8_SB(0, 0), b2, voffB);
            PG8_BAR; PG8_WAIT_L(0); PG8_MMA(0, 1, At, B1); PG8_BAR;
            PG8_LDA(At, 0, 1); PG8_STAGE(PG8_SA(0, 0), a2, voffA);
            PG8_BAR; PG8_WAIT_L(0); PG8_MMA(1, 0, At, B0); PG8_BAR; PG8_SCHED;
            PG8_STAGE(PG8_SB(0, 1), b2 + hstep, voffB);
            PG8_WAIT_V(6); PG8_BAR; PG8_MMA(1, 1, At, B1); PG8_BAR;
            PG8_LDB(B0, 1, 0); PG8_SCHED; PG8_LDA(At, 1, 0); PG8_STAGE(PG8_SA(0, 1), a2 + hstep, voffA);
            PG8_WAIT_L(8); PG8_BAR; PG8_WAIT_L(0); PG8_MMA(0, 0, At, B0); PG8_BAR; PG8_SCHED;
            PG8_LDB(B1, 1, 1); PG8_STAGE(PG8_SB(1, 0), b3, voffB);
            PG8_BAR; PG8_WAIT_L(0); PG8_MMA(0, 1, At, B1); PG8_BAR;
            PG8_LDA(At, 1, 1); PG8_STAGE(PG8_SA(1, 0), a3, voffA);
            PG8_BAR; PG8_WAIT_L(0); PG8_MMA(1, 0, At, B0); PG8_BAR; PG8_SCHED;
            PG8_STAGE(PG8_SB(1, 1), b3 + hstep, voffB);
            PG8_WAIT_V(6); PG8_BAR; PG8_MMA(1, 1, At, B1); PG8_BAR;
        }
        PG8_STAMP();
        if constexpr (!Epi::AFTER_DRAIN) { E(acc, cur, wr, wc, fr, fq); S.done(cur); }
        PG8_STAMP();
        if (!has_next) break;
#pragma unroll
        for (int a = 0; a < 2; ++a)
#pragma unroll
            for (int b = 0; b < 2; ++b)
#pragma unroll
                for (int m = 0; m < 4; ++m)
#pragma unroll
                    for (int n = 0; n < 2; ++n) acc[a][b][m][n] = (f32x4){0.f, 0.f, 0.f, 0.f};
        cur = nxt; cA = nA; cB = nB; ++ui;
    }
    PG8_WAIT_V(0);
    if (wr == 0) PG8_BAR;
    PG8_BAR;
    if constexpr (Epi::AFTER_DRAIN) { E.fused(acc, cur, wr, wc, fr, fq, lds, wid, lane); S.done(cur); }
    PG8_STAMP();
    if (STAMP && wid == 0) { stamps[lane] = lane < nts ? (((unsigned long long)(unsigned)ts_hi << 32) | (unsigned)ts_lo) : 0ull;
        if (lane == 62) stamps[62] = rt_entry; if (lane == 63) stamps[63] = (unsigned long long)wall_clock64(); }
#undef PG8_STAMP
#undef PG8_SA
#undef PG8_SB
#undef PG8_STAGE
#undef PG8_LDA
#undef PG8_LDB
#undef PG8_MMA
#undef PG8_WAIT_V
#undef PG8_WAIT_L
#undef PG8_BAR
#undef PG8_SCHED
}
}

namespace fa {
constexpr float SCALE = 0.08838834764831845f;
constexpr int D = 128, NW = 8, QBLK = 32, KVBLK = 64, QB = NW * QBLK;
constexpr int SHM_V = KVBLK * D * 2, SHM_K = KVBLK * D * 2;
constexpr int LDS_G = 2 * SHM_V + 2 * SHM_K + NW * 64 * 4;
constexpr int LDS_BYTES = LDS_G + 2048 * 4;
constexpr float THR2 = 11.5f;
typedef short bf16x8 __attribute__((ext_vector_type(8)));
typedef short s16x4 __attribute__((ext_vector_type(4)));
typedef float f32x16 __attribute__((ext_vector_type(16)));
typedef float f32x4 __attribute__((ext_vector_type(4)));
typedef unsigned u32x4 __attribute__((ext_vector_type(4)));
#define KSWZ(row, colB) ((row) * 256 + ((colB) ^ (((row) & 7) << 4)))
#define SBAR() __builtin_amdgcn_sched_barrier(0)
__device__ __forceinline__ int v_st(int k, int c) { const int kk = (k & ~0xC) | ((k & 4) << 1) | ((k & 8) >> 1); return ((kk >> 3) * 4 + (c >> 5)) * 512 + ((kk & 7) * 32 + (c & 31)) * 2; }
__device__ __forceinline__ int v_rd_base(int lane) { return ((lane & 3) << 3) | (((lane >> 2) & 3) << 6) | (((lane >> 4) & 1) << 5) | (((lane >> 5) & 1) << 8); }
constexpr int v_rd_off(int d0, int ks, int half) { return d0 * 512 + ks * 4096 + half * 2048; }
__device__ __forceinline__ int crow(int r, int hi) { return (r & 3) + 8 * (r >> 2) + 4 * hi; }
__device__ __forceinline__ unsigned cvtpk(float lo, float hi) { unsigned r; asm volatile("v_cvt_pk_bf16_f32 %0, %1, %2" : "=v"(r) : "v"(lo), "v"(hi)); return r; }
__device__ __forceinline__ bf16x8 load8(const bf16_t* p) { return *reinterpret_cast<const bf16x8*>(p); }
__device__ __forceinline__ void mask_tile(f32x16& p0, f32x16& p1, int dq, unsigned W) {
    const float NEG = -__builtin_inff();
#pragma unroll
    for (int r = 0; r < 16; ++r) {
        const int c = (r & 3) + 8 * (r >> 2);
        if ((unsigned)(dq - c) >= W) p0[r] = NEG;
        if ((unsigned)(dq - c - 32) >= W) p1[r] = NEG;
    }
}
__device__ __forceinline__ void partialSM(f32x16& p0, f32x16& p1, float& m_reg, float& mn, float& alpha, const LAS float* gk) {
    constexpr float C2 = 1.4426950408889634f * SCALE;
#pragma unroll
    for (int a4 = 0; a4 < 4; ++a4) { const f32x4 g0 = *(const LAS f32x4*)(gk + 8 * a4), g1 = *(const LAS f32x4*)(gk + 32 + 8 * a4);
#pragma unroll
        for (int b = 0; b < 4; ++b) { p0[4 * a4 + b] = fmaf(p0[4 * a4 + b], C2, g0[b]); p1[4 * a4 + b] = fmaf(p1[4 * a4 + b], C2, g1[b]); } }
    float pmax = p0[0]; for (int r = 1; r < 16; ++r) pmax = fmaxf(pmax, p0[r]); for (int r = 0; r < 16; ++r) pmax = fmaxf(pmax, p1[r]);
    { auto rr = __builtin_amdgcn_permlane32_swap(__float_as_uint(pmax), __float_as_uint(pmax), false, false);
      pmax = fmaxf(__uint_as_float(rr[0]), __uint_as_float(rr[1])); }
    if (__builtin_expect(__all(pmax - m_reg <= THR2), 1)) { mn = m_reg; alpha = 1.f; }
    else { mn = fmaxf(m_reg, pmax); alpha = __builtin_amdgcn_exp2f(m_reg - mn); m_reg = mn; }
    for (int r = 0; r < 16; ++r) p0[r] = p0[r] - mn; for (int r = 0; r < 16; ++r) p1[r] = p1[r] - mn;
    for (int r = 0; r < 16; ++r) p0[r] = __builtin_amdgcn_exp2f(p0[r]);
}
__device__ __forceinline__ void finishSM(f32x16& p0, f32x16& p1, float alpha, float& l_reg, bf16x8& pa0, bf16x8& pa1, bf16x8& pa2, bf16x8& pa3) {
    for (int r = 0; r < 16; ++r) p1[r] = __builtin_amdgcn_exp2f(p1[r]);
    float ps = 0; for (int r = 0; r < 16; ++r) ps += p0[r]; for (int r = 0; r < 16; ++r) ps += p1[r];
    { auto rr = __builtin_amdgcn_permlane32_swap(__float_as_uint(ps), __float_as_uint(ps), false, false);
      ps = __uint_as_float(rr[0]) + __uint_as_float(rr[1]); }
    l_reg = l_reg * alpha + ps;
#define PK4(P, B_, OUT) do { unsigned a0 = cvtpk(P[B_+0], P[B_+1]), a1 = cvtpk(P[B_+2], P[B_+3]);                          \
        unsigned b0 = cvtpk(P[B_+4], P[B_+5]), b1 = cvtpk(P[B_+6], P[B_+7]);                                             \
        auto r0 = __builtin_amdgcn_permlane32_swap(a0, b0, false, false); auto r1 = __builtin_amdgcn_permlane32_swap(a1, b1, false, false); \
        u32x4 w = {r0[0], r1[0], r0[1], r1[1]}; OUT = *reinterpret_cast<bf16x8*>(&w); } while (0)
    PK4(p0, 0, pa0); PK4(p0, 8, pa1); PK4(p1, 0, pa2); PK4(p1, 8, pa3);
#undef PK4
}
template <int KB>
__device__ __forceinline__ void qkt(f32x16& p0, f32x16& p1, const char* K_lds, int r32, int hi, const bf16x8* qr) {
    p0 = f32x16{}; p1 = f32x16{};
    const char* kb[4];
#pragma unroll
    for (int dd = 0; dd < 4; ++dd) kb[dd] = K_lds + KB * SHM_K + KSWZ(r32, (dd * 16 + hi * 8) * 2);
#pragma unroll
    for (int d0 = 0; d0 < 8; ++d0) { const char* a = kb[d0 & 3] + (d0 >> 2) * 128;
        bf16x8 b0 = *reinterpret_cast<const bf16x8*>(a);
        bf16x8 b1 = *reinterpret_cast<const bf16x8*>(a + 32 * 256);
        p0 = __builtin_amdgcn_mfma_f32_32x32x16_bf16(b0, qr[d0], p0, 0, 0, 0);
        p1 = __builtin_amdgcn_mfma_f32_32x32x16_bf16(b1, qr[d0], p1, 0, 0, 0); }
}
template <int VB>
__device__ __forceinline__ void pv_tile(f32x16* o, int vb0, bf16x8 pa0, bf16x8 pa1, bf16x8 pa2, bf16x8 pa3) {
#define TRRD(dst, off) asm volatile("ds_read_b64_tr_b16 %0, %1 offset:%2" : "=&v"(dst) : "v"(vb0), "i"(off) : "memory")
#define PV_D0(d0) do { s16x4 l0, l1, l2, l3, h0, h1, h2, h3; constexpr int b_ = VB * SHM_V + v_rd_off(d0, 0, 0); \
        TRRD(l0, b_); TRRD(h0, b_ + 2048); TRRD(l1, b_ + 4096); TRRD(h1, b_ + 6144); TRRD(l2, b_ + 8192); TRRD(h2, b_ + 10240); TRRD(l3, b_ + 12288); TRRD(h3, b_ + 14336); \
        asm volatile("s_waitcnt lgkmcnt(0)" ::: "memory"); SBAR();   \
        o[d0] = __builtin_amdgcn_mfma_f32_32x32x16_bf16(pa0, (bf16x8){l0[0], l0[1], l0[2], l0[3], h0[0], h0[1], h0[2], h0[3]}, o[d0], 0, 0, 0);   \
        o[d0] = __builtin_amdgcn_mfma_f32_32x32x16_bf16(pa1, (bf16x8){l1[0], l1[1], l1[2], l1[3], h1[0], h1[1], h1[2], h1[3]}, o[d0], 0, 0, 0);   \
        o[d0] = __builtin_amdgcn_mfma_f32_32x32x16_bf16(pa2, (bf16x8){l2[0], l2[1], l2[2], l2[3], h2[0], h2[1], h2[2], h2[3]}, o[d0], 0, 0, 0);   \
        o[d0] = __builtin_amdgcn_mfma_f32_32x32x16_bf16(pa3, (bf16x8){l3[0], l3[1], l3[2], l3[3], h3[0], h3[1], h3[2], h3[3]}, o[d0], 0, 0, 0); } while (0)
    PV_D0(0); PV_D0(1); PV_D0(2); PV_D0(3);
#undef PV_D0
#undef TRRD
}
struct BlockRef { const bf16_t* Q; const bf16_t* K; const bf16_t* V; bf16_t* O; const bf16_t* Z; int P0; };
struct Seam { bf16x8 qr[8]; bf16x8 st_v0, st_v1, st_k0, st_k1; };
#define ROW(p, k0, rr) ((const bf16_t*)((const char*)(p) + (unsigned)((((k0) + (rr)) * D + sc) * 2)))
#define VMW() asm volatile("s_waitcnt vmcnt(0)" ::: "memory")
#define VMWN(n) asm volatile("s_waitcnt vmcnt(%0)" :: "i"(n) : "memory")
#define SLOAD_H(Kp, Vp, k0) do { S.st_v0 = load8(ROW(Vp, k0, sr)); S.st_v1 = load8(ROW(Vp, k0, 32 + sr));              \
                         S.st_k0 = load8(ROW(Kp, k0, sr)); S.st_k1 = load8(ROW(Kp, k0, 32 + sr)); } while (0)
#define SWRITE_HK(bf) do { *(bf16x8*)(K_lds + (bf) * SHM_K + kws) = S.st_k0; *(bf16x8*)(K_lds + (bf) * SHM_K + kws + 32 * 256) = S.st_k1; } while (0)
#define SWRITE_HV(bf) do { *(bf16x8*)(V_lds + (bf) * SHM_V + vst0) = S.st_v0; *(bf16x8*)(V_lds + (bf) * SHM_V + vst1) = S.st_v1; } while (0)
#define SWRITE_H(bf) do { SWRITE_HV(bf); SWRITE_HK(bf); } while (0)
__device__ __forceinline__ void fox_prime(const BlockRef& cur, const float* Gsrc, char* lds, Seam& S) {
    const int tid = threadIdx.x, wid = __builtin_amdgcn_readfirstlane(tid >> 6), lane = tid & 63, r32 = lane & 31, hi = lane >> 5;
    const int sr = tid >> 4, sc = (tid & 15) * 8, kws = KSWZ(sr, sc * 2); char* K_lds = lds + 2 * SHM_V;
    *(f32x4*)(lds + LDS_G + tid * 16) = *(const f32x4*)(Gsrc + tid * 4);
    for (int d0 = 0; d0 < 8; ++d0) S.qr[d0] = load8((const bf16_t*)((const char*)cur.Q + (unsigned)(((wid * QBLK + r32) * D + d0 * 16 + hi * 8) * 2)));
    SLOAD_H(cur.K, cur.V, 0); VMW(); SWRITE_HK(0);
    __syncthreads();
}
__device__ __forceinline__ void fox_block(const BlockRef& cur, const BlockRef& nxt, char* lds, Seam& S) {
    constexpr int W = 1 << 30;
    const int tid = threadIdx.x, wid = __builtin_amdgcn_readfirstlane(tid >> 6), lane = tid & 63, r32 = lane & 31, hi = lane >> 5;
    const int NT = (cur.P0 + QB - 1) / KVBLK + 1;
    const int qlo = cur.P0 + wid * QBLK, qm = qlo + r32 - 4 * hi;
    char* V_lds = lds; char* K_lds = lds + 2 * SHM_V;
    float* ws = (float*)(lds + 2 * SHM_V + 2 * SHM_K) + wid * 64; float* li_l = ws, * al_l = ws + 32;
    const LAS float* Gl = (const LAS float*)(unsigned)(uintptr_t)(lds + LDS_G) + 4 * hi;
    float m_reg = -1e30f, l_reg = 0; f32x16 o[4] = {};
    const int sr = tid >> 4, sc = (tid & 15) * 8, vst0 = v_st(sr, sc), vst1 = v_st(32 + sr, sc), kws = KSWZ(sr, sc * 2);
    const int vb0 = (int)(uintptr_t)V_lds + v_rd_base(lane);
    const bf16_t* Kh = cur.K; const bf16_t* Vh = cur.V;
#define RESC(a) do { if (__any((a) < 1.f)) { if (hi == 0) al_l[r32] = (a); asm volatile("s_waitcnt lgkmcnt(0)" ::: "memory");              \
                     for (int d_ = 0; d_ < 4; ++d_) for (int r = 0; r < 16; ++r) o[d_][r] *= al_l[crow(r, hi)]; } } while (0)
#define KBASE(t) ((t) * KVBLK)
#define MASKT(P0_, P1_, t) do { const int kb_ = KBASE(t); if (kb_ + KVBLK - 1 > qlo) mask_tile(P0_, P1_, qm - kb_, (unsigned)W); } while (0)
    constexpr int NQL = 8;
#define SEAM_K0() do { VMWN(NQL); SWRITE_HK(0); SBAR(); } while (0)
    f32x16 pA0, pA1, pB0, pB1; float mnA, mnB, alA, alB; bf16x8 pa0, pa1, pa2, pa3;
    SWRITE_HV(0); SBAR();
    if (NT > 1) { SLOAD_H(Kh, Vh, KBASE(1)); }
    SBAR(); qkt<0>(pA0, pA1, K_lds, r32, hi, S.qr);
    MASKT(pA0, pA1, 0); partialSM(pA0, pA1, m_reg, mnA, alA, Gl + KBASE(0));
    if (NT > 1) { VMW(); SWRITE_H(1); }
    __syncthreads();
#define HALF_STEP(PX0, PX1, mnX, alX, PY0, PY1, alY, t, KB, VB, SB) do {                                                      \
        SBAR(); qkt<KB>(PX0, PX1, K_lds, r32, hi, S.qr);                                                        \
        finishSM(PY0, PY1, alY, l_reg, pa0, pa1, pa2, pa3); SBAR();                                                           \
        if ((t) + 1 < NT) { SLOAD_H(Kh, Vh, KBASE((t) + 1)); SBAR(); }                                                        \
        pv_tile<VB>(o, vb0, pa0, pa1, pa2, pa3); MASKT(PX0, PX1, (t)); partialSM(PX0, PX1, m_reg, mnX, alX, Gl + KBASE(t));    \
        __syncthreads();                                                                                                      \
        if ((t) + 1 < NT) { VMW(); SWRITE_H(SB); }                                                                            \
        RESC(alX); __syncthreads(); } while (0)
    for (int t = 1; t + 1 < NT; t += 2) {
        HALF_STEP(pB0, pB1, mnB, alB, pA0, pA1, alA, t, 1, 0, 0);
        HALF_STEP(pA0, pA1, mnA, alA, pB0, pB1, alB, t + 1, 0, 1, 1);
    }
    const bool even = (NT & 1) == 0;
    if (even) { SBAR(); qkt<1>(pB0, pB1, K_lds, r32, hi, S.qr); SBAR(); }
    SLOAD_H(nxt.K, nxt.V, 0); SBAR();
#pragma unroll
    for (int d0 = 0; d0 < 8; ++d0) S.qr[d0] = load8((const bf16_t*)((const char*)nxt.Q + (unsigned)(((wid * QBLK + r32) * D + d0 * 16 + hi * 8) * 2)));
    SBAR();
    finishSM(pA0, pA1, alA, l_reg, pa0, pa1, pa2, pa3); SBAR();
    pv_tile<0>(o, vb0, pa0, pa1, pa2, pa3);
    if (even) { MASKT(pB0, pB1, NT - 1); partialSM(pB0, pB1, m_reg, mnB, alB, Gl + KBASE(NT - 1)); __syncthreads(); RESC(alB);
        finishSM(pB0, pB1, alB, l_reg, pa0, pa1, pa2, pa3); SBAR(); pv_tile<1>(o, vb0, pa0, pa1, pa2, pa3); }
    SBAR(); SEAM_K0();
    if (hi == 0) li_l[r32] = l_reg; asm volatile("s_waitcnt lgkmcnt(0)" ::: "memory");
    float rli[16];
#pragma unroll
    for (int r = 0; r < 16; ++r) rli[r] = __builtin_amdgcn_rcpf(li_l[crow(r, hi)]);
    bf16_t* Ow = cur.O + (size_t)(wid * QBLK) * 1024; const bf16_t* Zw = cur.Z + (size_t)(wid * QBLK) * 512;
    const unsigned zo = (unsigned)(4 * hi * 512 + r32), oo = (unsigned)(4 * hi * 1024 + r32);
#pragma unroll
    for (int r = 0; r < 16; ++r) { constexpr int dummy = 0; const int cr = (r & 3) + 8 * (r >> 2);
        float zz[4];
#pragma unroll
        for (int d0 = 0; d0 < 4; ++d0) zz[d0] = bf2f(Zw[zo + (unsigned)(cr * 512 + d0 * 32)]);
#pragma unroll
        for (int d0 = 0; d0 < 4; ++d0) { const float z = zz[d0];
            const float v = o[d0][r] * rli[r] * z * __builtin_amdgcn_rcpf(1.f + __expf(-z));
            const float vn = __shfl_xor(v, 1);
            if ((r32 & 1) == 0) *(unsigned*)(Ow + oo + (unsigned)(cr * 1024 + d0 * 32)) = cvtpk(v, vn); }
        asm volatile("" ::: "memory"); }
    __syncthreads();
#undef RESC
#undef KBASE
#undef MASKT
#undef SEAM_K0
#undef HALF_STEP
}
#undef ROW
#undef VMW
#undef VMWN
#undef SLOAD_H
#undef SWRITE_HK
#undef SWRITE_HV
#undef SWRITE_H
#undef KSWZ
#undef SBAR
}


struct HalfBar { LAS unsigned* ctr; unsigned gen; };
__device__ __forceinline__ void hbar(HalfBar& hb) {
    __builtin_amdgcn_fence(__ATOMIC_RELEASE, "workgroup");
    if ((threadIdx.x & 63) == 0) __hip_atomic_fetch_add(hb.ctr, 1u, __ATOMIC_RELAXED, __HIP_MEMORY_SCOPE_WORKGROUP);
    hb.gen += 4u;
    while (__hip_atomic_load(hb.ctr, __ATOMIC_RELAXED, __HIP_MEMORY_SCOPE_WORKGROUP) < hb.gen) __builtin_amdgcn_s_sleep(1);
    __builtin_amdgcn_fence(__ATOMIC_ACQUIRE, "workgroup");
}

namespace dec {
constexpr float C2 = 0.08838834764831845f * 1.4426950408889634f;
typedef __attribute__((ext_vector_type(2))) __bf16 bf16x2;
typedef __attribute__((ext_vector_type(4))) unsigned u32x4;
typedef __attribute__((ext_vector_type(4))) float f32x4;
typedef __attribute__((ext_vector_type(8))) float f32x8;
constexpr int LDS_P = 0, LDS_MRG = 4 * 64, MRG_REC = 4 + 128, LDS_GP = LDS_MRG + 4 * 4 * MRG_REC, LDS_WS = LDS_GP + 2048, LDS_FLOATS = LDS_WS + 8;
__device__ __forceinline__ float dot2(unsigned k, unsigned q, float acc) { return __builtin_amdgcn_fdot2_f32_bf16(__builtin_bit_cast(bf16x2, k), __builtin_bit_cast(bf16x2, q), acc, false); }
__device__ __forceinline__ unsigned cvtpk(float lo, float hi) { unsigned r; asm volatile("v_cvt_pk_bf16_f32 %0, %1, %2" : "=v"(r) : "v"(lo), "v"(hi)); return r; }
template <int CTRL> __device__ __forceinline__ float dpp(float x) { return __builtin_bit_cast(float, __builtin_amdgcn_mov_dpp(__builtin_bit_cast(int, x), CTRL, 0xf, 0xf, true)); }
constexpr int XOR1 = 0xB1, XOR2 = 0x4E, XOR7 = 0x141, XOR8 = 0x128, ROR4 = 0x124;
__device__ __forceinline__ float xrow16_max(float x) {
    auto s = __builtin_amdgcn_permlane16_swap(__float_as_uint(x), __float_as_uint(x), false, false);
    x = fmaxf(__uint_as_float(s[0]), __uint_as_float(s[1]));
    auto t = __builtin_amdgcn_permlane32_swap(__float_as_uint(x), __float_as_uint(x), false, false);
    return fmaxf(__uint_as_float(t[0]), __uint_as_float(t[1]));
}
__device__ __forceinline__ float xrow16_sum(float x) {
    auto s = __builtin_amdgcn_permlane16_swap(__float_as_uint(x), __float_as_uint(x), false, false);
    x = __uint_as_float(s[0]) + __uint_as_float(s[1]);
    auto t = __builtin_amdgcn_permlane32_swap(__float_as_uint(x), __float_as_uint(x), false, false);
    return __uint_as_float(t[0]) + __uint_as_float(t[1]);
}
__device__ __forceinline__ u32x4 tobf(f32x8 x) { u32x4 w = {cvtpk(x[0], x[1]), cvtpk(x[2], x[3]), cvtpk(x[4], x[5]), cvtpk(x[6], x[7])}; return w; }
__device__ __forceinline__ f32x8 ld8nt(const float* p) { return __builtin_nontemporal_load(reinterpret_cast<const f32x8*>(p)); }

__device__ __forceinline__ void dec_item(const float* cache_k, const float* cache_v, const float* cache_logf, const int* pt_row, const bf16_t* q4  , const float* lfnew  ,
                                         const float* knew  , const float* vnew, const bf16_t* znew  , bf16_t* onew  ,
                                         int h, int split, float* dpart  , unsigned* dcnt, LAS float* lds, int t8, HalfBar& hb) {
    const int lane = t8 & 63, wave = __builtin_amdgcn_readfirstlane(t8 >> 6), r = lane >> 4, c = lane & 15;
    LAS float* gpast = lds + LDS_GP;
    {
        const int s0 = 8 * t8; const float* lf = cache_logf + ((size_t)pt_row[s0 >> 7] * 128 + (s0 & 127)) * 4 + h;
        float v[8]; float run = 0.f;
#pragma unroll
        for (int i = 0; i < 8; ++i) { run += lf[i * 4]; v[i] = run; }
        float incl = run;
#pragma unroll
        for (int o = 1; o < 64; o <<= 1) { const float t2 = __shfl_up(incl, o); if (lane >= o) incl += t2; }
        if (lane == 63) lds[LDS_WS + wave] = incl;
        hbar(hb);
        const float w0 = lds[LDS_WS], w1 = lds[LDS_WS + 1], w2 = lds[LDS_WS + 2], w3 = lds[LDS_WS + 3];
        const float off = (incl - run) + (wave > 0 ? w0 : 0.f) + (wave > 1 ? w1 : 0.f) + (wave > 2 ? w2 : 0.f);
        const float ftot = ((w0 + w1) + w2) + w3;
#pragma unroll
        for (int i = 0; i < 8; ++i) gpast[s0 + i] = (ftot - (v[i] + off)) * 1.4426950408889634f;
        hbar(hb);
    }
    int btv = 0;
    if (lane < 8) { const int sp = 32 * split + wave + 4 * lane; btv = pt_row[sp >> 3] * 128 + (sp & 7) * 16; }
    u32x4 qpk[4];
#pragma unroll
    for (int g = 0; g < 4; ++g) qpk[g] = *(const u32x4*)(q4 + g * 128 + 8 * c);
    const size_t loff = (size_t)r * 512 + (size_t)h * 128 + 8 * c;
    const int goff = r + 4 * (c >> 2);
#define ISSUE(i_) do { const int tb_ = __builtin_amdgcn_readlane(btv, (i_)); const float* kb_ = cache_k + (size_t)tb_ * 512 + loff; const float* vb_ = cache_v + (size_t)tb_ * 512 + loff; \
    _Pragma("unroll") for (int t_ = 0; t_ < 4; ++t_) { Kn[t_] = ld8nt(kb_ + (size_t)t_ * 4 * 512); Vn[t_] = ld8nt(vb_ + (size_t)t_ * 4 * 512); } \
    gsn = gpast[(32 * split + wave + 4 * (i_)) * 16 + goff]; } while (0)
    f32x8 Kn[4], Vn[4]; float gsn;
    float m = -INFINITY, l = 0.f, acc[32];
#pragma unroll
    for (int k = 0; k < 32; ++k) acc[k] = 0.f;
    ISSUE(0);
    for (int i = 0; i < 8; ++i) {
        u32x4 Kc[4], Vc[4];
#pragma unroll
        for (int t = 0; t < 4; ++t) { Kc[t] = tobf(Kn[t]); Vc[t] = tobf(Vn[t]); }
        const float gs = gsn;
        if (i + 1 < 8) ISSUE(i + 1);
        float x[16];
#pragma unroll
        for (int t = 0; t < 4; ++t)
#pragma unroll
            for (int g = 0; g < 4; ++g) { float d = 0.f;
#pragma unroll
                for (int k = 0; k < 4; ++k) d = dot2(Kc[t][k], qpk[g][k], d);
                x[t * 4 + g] = d; }
#define TR_STEP(HALF, CTRL, BIT) _Pragma("unroll") for (int hh = 0; hh < (HALF); ++hh) { \
      const float lo_ = x[hh], hi_ = x[hh + (HALF)]; const float t1_ = lo_ + dpp<CTRL>(lo_), t2_ = hi_ + dpp<CTRL>(hi_); \
      x[hh] = (c & (BIT)) ? t2_ : t1_; }
        TR_STEP(8, XOR8, 8) TR_STEP(4, XOR7, 4) TR_STEP(2, XOR2, 2) TR_STEP(1, XOR1, 1)
#undef TR_STEP
        const float sc = fmaf(x[0], C2, gs);
        float pm = sc; pm = fmaxf(pm, dpp<ROR4>(pm)); pm = fmaxf(pm, dpp<XOR8>(pm)); pm = xrow16_max(pm);
        const float mn = fmaxf(m, pm);
        const float alpha = __builtin_amdgcn_exp2f(m - mn), p = __builtin_amdgcn_exp2f(sc - mn);
        l = fmaf(l, alpha, p); m = mn;
#pragma unroll
        for (int q4i = 0; q4i < 4; ++q4i) {
            const float al = q4i == 0 ? dpp<0x00>(alpha) : q4i == 1 ? dpp<0x55>(alpha) : q4i == 2 ? dpp<0xAA>(alpha) : dpp<0xFF>(alpha);
#pragma unroll
            for (int k = 0; k < 8; ++k) acc[q4i * 8 + k] *= al; }
        LAS float* prow = lds + LDS_P + (wave * 4 + r) * 16;
        prow[c] = p;
        asm volatile("s_waitcnt lgkmcnt(0)" ::: "memory");
        f32x4 pr[4];
#pragma unroll
        for (int u = 0; u < 4; ++u) pr[u] = *reinterpret_cast<const LAS f32x4*>(prow + 4 * u);
#pragma unroll
        for (int t = 0; t < 4; ++t) {
            float vf[8];
#pragma unroll
            for (int k = 0; k < 4; ++k) { vf[2 * k] = __builtin_bit_cast(float, Vc[t][k] << 16); vf[2 * k + 1] = __builtin_bit_cast(float, Vc[t][k] & 0xffff0000u); }
#pragma unroll
            for (int g = 0; g < 4; ++g) { const float pg_ = pr[t][g];
#pragma unroll
                for (int k = 0; k < 8; ++k) acc[g * 8 + k] = fmaf(pg_, vf[k], acc[g * 8 + k]); } }
    }
#undef ISSUE
#pragma unroll
    for (int k = 0; k < 32; ++k) acc[k] = xrow16_sum(acc[k]);
    { float t = l; t += dpp<ROR4>(t); t += dpp<XOR8>(t); l = xrow16_sum(t); }
    LAS float* mrg = lds + LDS_MRG;
    if (r == 0) {
#pragma unroll
        for (int g = 0; g < 4; ++g) {
            LAS float* rec = mrg + (wave * 4 + g) * MRG_REC;
#pragma unroll
            for (int k = 0; k < 8; k += 4) *reinterpret_cast<LAS f32x4*>(rec + 4 + 8 * c + k) = f32x4{acc[g * 8 + k], acc[g * 8 + k + 1], acc[g * 8 + k + 2], acc[g * 8 + k + 3]};
            if (c == g) { rec[0] = m; rec[1] = l; } } }
    hbar(hb);
    {
        const int g = wave, d0 = 2 * lane;
        float M = -INFINITY;
#pragma unroll
        for (int w = 0; w < 4; ++w) M = fmaxf(M, mrg[(w * 4 + g) * MRG_REC]);
        float L = 0.f, o0 = 0.f, o1 = 0.f;
#pragma unroll
        for (int w = 0; w < 4; ++w) { const LAS float* rec = mrg + (w * 4 + g) * MRG_REC; const float lw = rec[1];
            const float wt = __builtin_amdgcn_exp2f(rec[0] - M);
            L = fmaf(wt, lw, L); o0 = fmaf(wt, rec[4 + d0], o0); o1 = fmaf(wt, rec[4 + d0 + 1], o1); }
        { unsigned long long* pp = (unsigned long long*)(dpart + (split * 4 + g) * 132);
          __hip_atomic_store(pp + 2 + lane, __builtin_bit_cast(unsigned long long, make_float2(o0, o1)), __ATOMIC_RELAXED, __HIP_MEMORY_SCOPE_AGENT);
          if (lane == 0) __hip_atomic_store(pp, __builtin_bit_cast(unsigned long long, make_float2(M, L)), __ATOMIC_RELAXED, __HIP_MEMORY_SCOPE_AGENT); }
        asm volatile("s_waitcnt vmcnt(0)" ::: "memory");
        hbar(hb);
        if (t8 == 0) ((LAS unsigned*)lds)[LDS_WS + 4] = __hip_atomic_fetch_add(dcnt, 1u, __ATOMIC_RELAXED, __HIP_MEMORY_SCOPE_AGENT);
        hbar(hb);
        if ((((LAS unsigned*)lds)[LDS_WS + 4] & 3u) != 3u) return;
        M = -INFINITY;
        float pm[4], pl[4]; float2 po[4];
#pragma unroll
        for (int sidx = 0; sidx < 4; ++sidx) { const unsigned long long* pp = (const unsigned long long*)(dpart + (sidx * 4 + g) * 132);
            const float2 ml = __builtin_bit_cast(float2, __hip_atomic_load(pp, __ATOMIC_RELAXED, __HIP_MEMORY_SCOPE_AGENT));
            po[sidx] = __builtin_bit_cast(float2, __hip_atomic_load(pp + 2 + lane, __ATOMIC_RELAXED, __HIP_MEMORY_SCOPE_AGENT));
            pm[sidx] = ml.x; pl[sidx] = ml.y; M = fmaxf(M, ml.x); }
        L = 0.f; o0 = 0.f; o1 = 0.f;
#pragma unroll
        for (int sidx = 0; sidx < 4; ++sidx) { const float wt = __builtin_amdgcn_exp2f(pm[sidx] - M); L = fmaf(wt, pl[sidx], L); o0 = fmaf(wt, po[sidx].x, o0); o1 = fmaf(wt, po[sidx].y, o1); }
        const float q0 = bf2f(q4[g * 128 + d0]), q1 = bf2f(q4[g * 128 + d0 + 1]);
        float fnew = 0.f;
        for (int j = 0; j <= g; ++j) {
            fnew += lfnew[j * 4];
            const float2 kk = *(const float2*)(knew + (size_t)j * 512 + h * 128 + d0), vv = *(const float2*)(vnew + (size_t)j * 512 + h * 128 + d0);
            float d = q0 * kk.x + q1 * kk.y;
#pragma unroll
            for (int o = 1; o < 64; o <<= 1) d += __shfl_xor(d, o);
            const float sc = fmaf(d, C2, -fnew * 1.4426950408889634f);
            const float mn = fmaxf(M, sc), wo = __builtin_amdgcn_exp2f(M - mn), p = __builtin_amdgcn_exp2f(sc - mn);
            L = fmaf(L, wo, p); o0 = fmaf(o0, wo, p * vv.x); o1 = fmaf(o1, wo, p * vv.y); M = mn;
        }
        const float inv = 1.f / L;
        const float z0 = bf2f(znew[(size_t)g * 512 + h * 128 + d0]), z1 = bf2f(znew[(size_t)g * 512 + h * 128 + d0 + 1]);
        *(unsigned*)(onew + (size_t)g * 1024 + 512 + h * 128 + d0) = cvtpk(o0 * inv * (z0 / (1.f + __expf(-z0))), o1 * inv * (z1 / (1.f + __expf(-z1))));
    }
}
}


namespace gdn {
#define LBAR() do { asm volatile("s_waitcnt lgkmcnt(0)" ::: "memory"); __builtin_amdgcn_s_barrier(); asm volatile("" ::: "memory"); } while (0)
typedef short bf16x8 __attribute__((ext_vector_type(8)));
typedef float f32x4 __attribute__((ext_vector_type(4)));
typedef unsigned u32x4 __attribute__((ext_vector_type(4)));
constexpr int L_QS = 0, L_KS = 17408, L_VS = 34816, L_AM = 51200, L_GC = 67584, L_BT = 67840, L_EG = 68096, L_EK = 68352, L_HALF = 68608;
__device__ __forceinline__ int pos32(int c) { return ((c >> 2) & 3) * 8 + (c >> 4) * 4 + (c & 3); }
typedef __bf16 bf16x2_t __attribute__((ext_vector_type(2)));
typedef float f32x2_t __attribute__((ext_vector_type(2)));
__device__ __forceinline__ unsigned cvtpk(float lo, float hi) { const f32x2_t v = {lo, hi}; return __builtin_bit_cast(unsigned, __builtin_convertvector(v, bf16x2_t)); }
__device__ __forceinline__ bf16x8 pack8(const f32x4 a, const f32x4 b) { u32x4 w = {cvtpk(a[0], a[1]), cvtpk(a[2], a[3]), cvtpk(b[0], b[1]), cvtpk(b[2], b[3])}; return *reinterpret_cast<bf16x8*>(&w); }
__device__ __forceinline__ float bfe(const bf16x8 v, int e) { return __uint_as_float(((unsigned)(unsigned short)v[e]) << 16); }

__device__ __forceinline__ void chunk_item(const bf16_t* QKVG, const float* conv_w, const float* BETA, const float* GG, bf16_t* WN, bf16_t* QD, bf16_t* KDT, bf16_t* QKM, float* UT, float* GL,
                                           int b, int h, int n, LAS unsigned char* L, int t8) {
    const int lane = t8 & 63, w4 = __builtin_amdgcn_readfirstlane(t8 >> 6);
    const int ci = (b * 4 + h) * 32 + n; const int row0 = b * SEQ + n * 64;
    LAS bf16_t* QS = (LAS bf16_t*)(L + L_QS); LAS bf16_t* KS = (LAS bf16_t*)(L + L_KS); LAS bf16_t* VS = (LAS bf16_t*)(L + L_VS);
    LAS float* AM = (LAS float*)(L + L_AM); LAS float* GC = (LAS float*)(L + L_GC); LAS float* BT = (LAS float*)(L + L_BT); LAS float* EG = (LAS float*)(L + L_EG); LAS float* EK = (LAS float*)(L + L_EK);
    {
        const int cg = t8 & 15, tg = t8 >> 4;
#pragma unroll
        for (int sec = 0; sec < 3; ++sec) {
            const int cb = sec * 512 + h * 128 + 8 * cg;
            bf16x8 xr[7];
#pragma unroll
            for (int j = 0; j < 7; ++j) { const int tt = n * 64 + 4 * tg - 3 + j;
                xr[j] = tt >= 0 ? *(const bf16x8*)(QKVG + (size_t)(b * SEQ + tt) * CONV_DIM + cb) : (bf16x8){0, 0, 0, 0, 0, 0, 0, 0}; }
            float w[4][8];
#pragma unroll
            for (int j = 0; j < 4; ++j) { const f32x4 w0 = *(const f32x4*)(conv_w + j * CONV_DIM + cb), w1 = *(const f32x4*)(conv_w + j * CONV_DIM + cb + 4);
                w[j][0] = w0[0]; w[j][1] = w0[1]; w[j][2] = w0[2]; w[j][3] = w0[3]; w[j][4] = w1[0]; w[j][5] = w1[1]; w[j][6] = w1[2]; w[j][7] = w1[3]; }
#pragma unroll
            for (int tk = 0; tk < 4; ++tk) {
                float y[8]; float ss = 0.f;
#pragma unroll
                for (int e = 0; e < 8; ++e) { float acc = 0.f;
#pragma unroll
                    for (int j = 0; j < 4; ++j) acc = fmaf(w[j][e], bfe(xr[tk + j], e), acc);
                    y[e] = acc / (1.f + __expf(-acc)); ss = fmaf(y[e], y[e], ss); }
                if (sec < 2) { ss += __shfl_xor(ss, 1); ss += __shfl_xor(ss, 2); ss += __shfl_xor(ss, 4); ss += __shfl_xor(ss, 8);
                    const float rn = rsqrtf(ss + 1e-6f) * (sec == 0 ? 0.08838834764831845f : 1.f);
#pragma unroll
                    for (int e = 0; e < 8; ++e) y[e] *= rn; }
                const u32x4 pk = {cvtpk(y[0], y[1]), cvtpk(y[2], y[3]), cvtpk(y[4], y[5]), cvtpk(y[6], y[7])};
                const int tok = 4 * tg + tk;
                if (sec == 0) *(LAS u32x4*)(QS + tok * 136 + 8 * cg) = pk; else if (sec == 1) *(LAS u32x4*)(KS + tok * 136 + 8 * cg) = pk; else *(LAS u32x4*)(VS + tok * 128 + 8 * cg) = pk;
            }
        }
    }
    if (w4 == 0) {
        float gc = GG[(size_t)(row0 + lane) * 4 + h];
#pragma unroll
        for (int o = 1; o < 64; o <<= 1) { const float t2 = __shfl_up(gc, o); if (lane >= o) gc += t2; }
        const float gl = __shfl(gc, 63);
        GC[lane] = gc; BT[lane] = BETA[(size_t)(row0 + lane) * 4 + h]; EG[lane] = __expf(gc); EK[lane] = __expf(gl - gc);
        if (lane == 63) GL[(size_t)ci * 32] = __expf(gc);
    }
    LBAR();
    {
        const int n16 = lane & 15, g = lane >> 4, mi = w4;
        bf16_t* qkm = QKM + (size_t)ci * 4096;
        for (int nj = 0; nj < 4; ++nj) {
            const int j = 16 * nj + n16; const int jp = 32 * (j >> 5) + pos32(j & 31);
            if (nj <= mi) {
                f32x4 akk = {0.f, 0.f, 0.f, 0.f}, aqk = {0.f, 0.f, 0.f, 0.f};
#pragma unroll
                for (int kk = 0; kk < 4; ++kk) {
                    const bf16x8 ak = *(const LAS bf16x8*)(KS + (16 * mi + n16) * 136 + 32 * kk + 8 * g), aq = *(const LAS bf16x8*)(QS + (16 * mi + n16) * 136 + 32 * kk + 8 * g);
                    const bf16x8 bb = *(const LAS bf16x8*)(KS + (16 * nj + n16) * 136 + 32 * kk + 8 * g);
                    akk = __builtin_amdgcn_mfma_f32_16x16x32_bf16(ak, bb, akk, 0, 0, 0); aqk = __builtin_amdgcn_mfma_f32_16x16x32_bf16(aq, bb, aqk, 0, 0, 0); }
                const float gcj = GC[j];
#pragma unroll
                for (int r = 0; r < 4; ++r) { const int i = 16 * mi + 4 * g + r; const float dec = __expf(fminf(GC[i] - gcj, 0.f));
                    AM[i * 64 + j] = (i > j) ? BT[i] * akk[r] * dec : 0.f;
                    qkm[i * 64 + jp] = (bf16_t)f2bf((i >= j) ? aqk[r] * dec : 0.f); }
            } else {
#pragma unroll
                for (int r = 0; r < 4; ++r) { const int i = 16 * mi + 4 * g + r; qkm[i * 64 + jp] = 0; }
            }
        }
        { const int tok = t8 >> 2, qt = t8 & 3; const float e = EG[tok]; float q[32];
#pragma unroll
          for (int v = 0; v < 4; ++v) { const bf16x8 x = *(const LAS bf16x8*)(QS + tok * 136 + 32 * qt + 8 * v);
#pragma unroll
              for (int k = 0; k < 8; ++k) q[8 * v + k] = bfe(x, k) * e; }
#pragma unroll
          for (int gg = 0; gg < 4; ++gg) { const u32x4 o = {cvtpk(q[4 * gg], q[4 * gg + 1]), cvtpk(q[4 * gg + 2], q[4 * gg + 3]), cvtpk(q[16 + 4 * gg], q[16 + 4 * gg + 1]), cvtpk(q[16 + 4 * gg + 2], q[16 + 4 * gg + 3])};
              *(u32x4*)(QD + (size_t)ci * 8192 + tok * 128 + 32 * qt + 8 * gg) = o; } }
        { const int dk = t8 & 127, th = t8 >> 7; float kv[32];
#pragma unroll
          for (int c = 0; c < 32; ++c) kv[c] = bf2f(KS[(32 * th + c) * 136 + dk]) * EK[32 * th + c];
#pragma unroll
          for (int gg = 0; gg < 4; ++gg) { const u32x4 o = {cvtpk(kv[4 * gg], kv[4 * gg + 1]), cvtpk(kv[4 * gg + 2], kv[4 * gg + 3]), cvtpk(kv[16 + 4 * gg], kv[16 + 4 * gg + 1]), cvtpk(kv[16 + 4 * gg + 2], kv[16 + 4 * gg + 3])};
              *(u32x4*)(KDT + (size_t)ci * 8192 + dk * 64 + 32 * th + 8 * gg) = o; } }
    }
    LBAR();
    {
        const int c = t8; float x[64];
        if (c < 128) {
#pragma unroll
            for (int r = 0; r < 64; ++r) x[r] = BT[r] * bf2f(VS[r * 128 + c]);
        } else {
#pragma unroll
            for (int r = 0; r < 64; ++r) x[r] = BT[r] * EG[r] * bf2f(KS[r * 136 + (c - 128)]);
        }
#pragma unroll
        for (int r = 1; r < 64; ++r) {
#pragma unroll
            for (int k4 = 0; k4 < (r + 3) / 4; ++k4) { const f32x4 a4 = *(const LAS f32x4*)(AM + r * 64 + 4 * k4);
#pragma unroll
                for (int e = 0; e < 4; ++e) if (4 * k4 + e < r) x[r] = fmaf(-a4[e], x[4 * k4 + e], x[r]); }
        }
        if (c < 128) { float* u = UT + (size_t)ci * 8192 + c * 64;
#pragma unroll
            for (int r = 0; r < 64; r += 4) *(f32x4*)(u + r) = (f32x4){x[r], x[r + 1], x[r + 2], x[r + 3]}; }
        else { const int dk = c - 128, dp = 32 * (dk >> 5) + pos32(dk & 31);
#pragma unroll
            for (int r = 0; r < 64; ++r) QS[r * 136 + dp] = (bf16_t)f2bf(-x[r]); }
    }
    LBAR();
    {
#pragma unroll
        for (int i = 0; i < 4; ++i) { const int q = i * 256 + t8, row = q >> 4, cc = q & 15;
            *(u32x4*)(WN + (size_t)ci * 8192 + row * 128 + cc * 8) = *(const LAS u32x4*)(QS + row * 136 + cc * 8); }
    }
    LBAR();
}

constexpr int S_WN = 0, S_QD = 17408, S_KDT = 34816, S_QKM = 53248, S_OT = 62464, S_BYTES = 62464 + 64 * 132 * 4;
__device__ __forceinline__ void scan_head(const bf16_t* WN, const bf16_t* QD, const bf16_t* KDT, const bf16_t* QKM, const float* UT, const float* GL,
                                          const bf16_t* ZG, const float* onw, bf16_t* OMIX, float* ssm_out, int b, int h, LAS unsigned char* L) {
    const int tid = threadIdx.x, lane = tid & 63, wave = __builtin_amdgcn_readfirstlane(tid >> 6), n16 = lane & 15, g = lane >> 4, dv0 = 16 * wave;
    const int ci0 = (b * 4 + h) * 32;
    LAS float* OT = (LAS float*)(L + S_OT);
    u32x4 st[7];
#define SC_LOAD(nn) do { const size_t cb_ = (size_t)(ci0 + (nn)) * 8192; \
        st[0] = *(const u32x4*)(WN + cb_ + (size_t)tid * 8); st[1] = *(const u32x4*)(WN + cb_ + (size_t)(512 + tid) * 8); \
        st[2] = *(const u32x4*)(QD + cb_ + (size_t)tid * 8); st[3] = *(const u32x4*)(QD + cb_ + (size_t)(512 + tid) * 8); \
        st[4] = *(const u32x4*)(KDT + cb_ + (size_t)tid * 8); st[5] = *(const u32x4*)(KDT + cb_ + (size_t)(512 + tid) * 8); \
        st[6] = *(const u32x4*)(QKM + (size_t)(ci0 + (nn)) * 4096 + (size_t)tid * 8); } while (0)
#define SC_WRITE() do { \
        *(LAS u32x4*)(L + S_WN + (tid >> 4) * 272 + (tid & 15) * 16) = st[0]; *(LAS u32x4*)(L + S_WN + (32 + (tid >> 4)) * 272 + (tid & 15) * 16) = st[1]; \
        *(LAS u32x4*)(L + S_QD + (tid >> 4) * 272 + (tid & 15) * 16) = st[2]; *(LAS u32x4*)(L + S_QD + (32 + (tid >> 4)) * 272 + (tid & 15) * 16) = st[3]; \
        *(LAS u32x4*)(L + S_KDT + (tid >> 3) * 144 + (tid & 7) * 16) = st[4]; *(LAS u32x4*)(L + S_KDT + (64 + (tid >> 3)) * 144 + (tid & 7) * 16) = st[5]; \
        *(LAS u32x4*)(L + S_QKM + (tid >> 3) * 144 + (tid & 7) * 16) = st[6]; } while (0)
    f32x4 Sacc[8];
#pragma unroll
    for (int i = 0; i < 8; ++i) Sacc[i] = (f32x4){0.f, 0.f, 0.f, 0.f};
    typedef float f32x2 __attribute__((ext_vector_type(2)));
    const int tl = lane >> 3, dg = lane & 7;
    f32x4 onw4[4];
#pragma unroll
    for (int j = 0; j < 4; ++j) onw4[j] = *(const f32x4*)(onw + 16 * dg + 4 * j);
    const float* utb = UT + (size_t)ci0 * 8192 + (size_t)(dv0 + n16) * 64 + 4 * g;
    const bf16_t* zgb = ZG + ((size_t)b * SEQ + 8 * wave + tl) * 512 + h * 128 + 16 * dg;
    bf16_t* omb = OMIX + ((size_t)b * SEQ + 8 * wave + tl) * 1024 + h * 128 + 16 * dg;
    f32x4 utn[4];
    SC_LOAD(0); SC_WRITE();
#pragma unroll
    for (int mt = 0; mt < 4; ++mt) utn[mt] = *(const f32x4*)(utb + 16 * mt);
    float gln = GL[(size_t)ci0 * 32];
    LBAR();
    for (int n = 0; n < 32; ++n) {
        f32x4 vn[4];
#pragma unroll
        for (int mt = 0; mt < 4; ++mt) vn[mt] = utn[mt];
        const float gl = gln;
        if (n + 1 < 32) { SC_LOAD(n + 1);
#pragma unroll
            for (int mt = 0; mt < 4; ++mt) utn[mt] = *(const f32x4*)(utb + (size_t)(n + 1) * 8192 + 16 * mt);
            gln = GL[(size_t)(ci0 + n + 1) * 32]; }
        const u32x4 zp0 = *(const u32x4*)(zgb + (size_t)n * 64 * 512), zp1 = *(const u32x4*)(zgb + (size_t)n * 64 * 512 + 8);
        __builtin_amdgcn_sched_barrier(0);
        bf16x8 bS[4];
#pragma unroll
        for (int kk = 0; kk < 4; ++kk) bS[kk] = pack8(Sacc[2 * kk], Sacc[2 * kk + 1]);
#define RD4(dst, base, row, stride) do { _Pragma("unroll") for (int kk_ = 0; kk_ < 4; ++kk_) dst[kk_] = *(const LAS bf16x8*)(L + (base) + (row) * (stride) + (32 * kk_ + 8 * g) * 2); } while (0)
#define RD2(dst, base, row, stride) do { _Pragma("unroll") for (int kk_ = 0; kk_ < 2; ++kk_) dst[kk_] = *(const LAS bf16x8*)(L + (base) + (row) * (stride) + (32 * kk_ + 8 * g) * 2); } while (0)
        bf16x8 fa4[4], fb4[4];
        RD4(fa4, S_WN, n16, 272);
#pragma unroll
        for (int mt = 0; mt < 4; ++mt) {
            if (mt < 3) RD4(fb4, S_WN, 16 * (mt + 1) + n16, 272); else RD4(fb4, S_QD, n16, 272);
#pragma unroll
            for (int kk = 0; kk < 4; ++kk) vn[mt] = __builtin_amdgcn_mfma_f32_16x16x32_bf16(fa4[kk], bS[kk], vn[mt], 0, 0, 0);
#pragma unroll
            for (int kk = 0; kk < 4; ++kk) fa4[kk] = fb4[kk];
        }
        f32x4 o[4];
#pragma unroll
        for (int mt = 0; mt < 4; ++mt) {
            o[mt] = (f32x4){0.f, 0.f, 0.f, 0.f};
            if (mt < 3) RD4(fb4, S_QD, 16 * (mt + 1) + n16, 272); else { RD2(fb4, S_QKM, n16, 144); fb4[2] = fb4[0]; fb4[3] = fb4[1]; }
#pragma unroll
            for (int kk = 0; kk < 4; ++kk) o[mt] = __builtin_amdgcn_mfma_f32_16x16x32_bf16(fa4[kk], bS[kk], o[mt], 0, 0, 0);
#pragma unroll
            for (int kk = 0; kk < 4; ++kk) fa4[kk] = fb4[kk];
        }
        bf16x8 bV[2];
        bV[0] = pack8(vn[0], vn[1]); bV[1] = pack8(vn[2], vn[3]);
#pragma unroll
        for (int mt = 0; mt < 4; ++mt) {
            if (mt < 3) RD2(fb4, S_QKM, 16 * (mt + 1) + n16, 144); else RD2(fb4, S_KDT, n16, 144);
#pragma unroll
            for (int k2 = 0; k2 < 2; ++k2) o[mt] = __builtin_amdgcn_mfma_f32_16x16x32_bf16(fa4[k2], bV[k2], o[mt], 0, 0, 0);
            fa4[0] = fb4[0]; fa4[1] = fb4[1];
        }
#pragma unroll
        for (int m8 = 0; m8 < 8; ++m8) { Sacc[m8] = Sacc[m8] * gl;
            if (m8 < 7) RD2(fb4, S_KDT, 16 * (m8 + 1) + n16, 144);
#pragma unroll
            for (int k2 = 0; k2 < 2; ++k2) Sacc[m8] = __builtin_amdgcn_mfma_f32_16x16x32_bf16(fa4[k2], bV[k2], Sacc[m8], 0, 0, 0);
            fa4[0] = fb4[0]; fa4[1] = fb4[1];
        }
#undef RD4
#undef RD2
#pragma unroll
        for (int mt = 0; mt < 4; ++mt)
#pragma unroll
            for (int r = 0; r < 4; ++r) OT[(16 * mt + 4 * g + r) * 132 + dv0 + n16] = o[mt][r];
        LBAR();
        if (n + 1 < 32) SC_WRITE();
        {
            f32x4 ov[4]; float ss = 0.f;
#pragma unroll
            for (int j = 0; j < 4; ++j) { ov[j] = *(const LAS f32x4*)(OT + (8 * wave + tl) * 132 + 16 * dg + 4 * j);
                ss += (ov[j][0] * ov[j][0] + ov[j][1] * ov[j][1]) + (ov[j][2] * ov[j][2] + ov[j][3] * ov[j][3]); }
            ss += __shfl_xor(ss, 1); ss += __shfl_xor(ss, 2); ss += __shfl_xor(ss, 4);
            const float rr = rsqrtf(ss * (1.f / 128.f) + 1e-6f);
            unsigned ow[8];
#pragma unroll
            for (int j = 0; j < 4; ++j) {
                const unsigned za = j < 2 ? zp0[2 * j] : zp1[2 * j - 4], zb = j < 2 ? zp0[2 * j + 1] : zp1[2 * j - 3];
                const float z0 = __uint_as_float(za << 16), z1 = __uint_as_float(za & 0xffff0000u), z2 = __uint_as_float(zb << 16), z3 = __uint_as_float(zb & 0xffff0000u);
                const float g0 = z0 * __builtin_amdgcn_rcpf(1.f + __expf(-z0)), g1 = z1 * __builtin_amdgcn_rcpf(1.f + __expf(-z1));
                const float g2 = z2 * __builtin_amdgcn_rcpf(1.f + __expf(-z2)), g3 = z3 * __builtin_amdgcn_rcpf(1.f + __expf(-z3));
                ow[2 * j] = cvtpk(ov[j][0] * rr * onw4[j][0] * g0, ov[j][1] * rr * onw4[j][1] * g1);
                ow[2 * j + 1] = cvtpk(ov[j][2] * rr * onw4[j][2] * g2, ov[j][3] * rr * onw4[j][3] * g3); }
            *(u32x4*)(omb + (size_t)n * 64 * 1024) = (u32x4){ow[0], ow[1], ow[2], ow[3]};
            *(u32x4*)(omb + (size_t)n * 64 * 1024 + 8) = (u32x4){ow[4], ow[5], ow[6], ow[7]};
        }
        LBAR();
    }
#undef SC_LOAD
#undef SC_WRITE
#pragma unroll
    for (int m8 = 0; m8 < 8; ++m8)
#pragma unroll
        for (int r = 0; r < 4; ++r) ssm_out[(size_t)(16 * m8 + 4 * g + r) * 128 + dv0 + n16] = Sacc[m8][r];
}
#undef LBAR
}

#define XB_TMO      128
#define XB_XCNT(j)  (256  + 64 * (j))
#define XB_XSUB(j)  (1280 + 64 * (j))
#define XB_XGEN(j)  (2304 + 64 * (j))
#define XB_TOP      3328
#define XB_TOPGEN   3392
#define XCD_BAR_WORDS 3456
#define XB_SPIN_CAP (1u << 24)

__device__ __forceinline__ unsigned xb_ld(unsigned* p)              { return __hip_atomic_load(p, __ATOMIC_RELAXED, __HIP_MEMORY_SCOPE_AGENT); }
__device__ __forceinline__ unsigned xb_add(unsigned* p, unsigned v) { return __hip_atomic_fetch_add(p, v, __ATOMIC_RELAXED, __HIP_MEMORY_SCOPE_AGENT); }
__device__ __forceinline__ unsigned xb_xcc_id() { return (unsigned)__builtin_amdgcn_s_getreg((3 << 11) | 20) & 0xFu; }
#define XB_SPIN(cond, bar) do { unsigned _sp = 0; while (cond) { __builtin_amdgcn_s_sleep(1); \
    if ((++_sp & 255u) == 0u) { if (xb_ld(&(bar)[XB_TMO])) break; if (_sp > XB_SPIN_CAP) { atomicAdd(&(bar)[XB_TMO], 1u); break; } } } } while (0)

struct XcdBarrier {
    unsigned* bar; unsigned x;
    volatile LAS unsigned* st;
};

__device__ __forceinline__ XcdBarrier xcd_barrier_post(unsigned* bar, volatile LAS unsigned* st) {
    XcdBarrier b; b.bar = bar; b.x = xb_xcc_id(); b.st = st;
    if (threadIdx.x == 0) (void)xb_add(&bar[XB_XCNT(b.x)], 1u);
    return b;
}
__device__ __forceinline__ void xcd_barrier_complete(unsigned* bar, unsigned x, unsigned& nloc, unsigned& nx) {
    const unsigned G = gridDim.x * gridDim.y * gridDim.z;
    unsigned sum, cnt, mine, sp = 0u;
    for (;;) {
        sum = 0u; cnt = 0u; mine = 0u;
#pragma unroll
        for (unsigned j = 0; j < 16; ++j) { const unsigned c = xb_ld(&bar[XB_XCNT(j)]); sum += c; cnt += (c > 0u) ? 1u : 0u; mine = (j == x) ? c : mine; }
        if (sum == G) break;
        __builtin_amdgcn_s_sleep(1);
        if ((++sp & 255u) == 0u) { if (xb_ld(&bar[XB_TMO])) break; if (sp > XB_SPIN_CAP) { atomicAdd(&bar[XB_TMO], 1u); break; } }
    }
    nloc = mine > 0u ? mine : 1u; nx = cnt > 0u ? cnt : 1u;
}

__device__ __forceinline__ void xcd_barrier(const XcdBarrier& b) {
    asm volatile("s_waitcnt vmcnt(0)" ::: "memory");
    __syncthreads();
    if (threadIdx.x == 0) {
        unsigned* bar = b.bar;
        __builtin_amdgcn_s_waitcnt(0);
        unsigned nloc = b.st[0], nx = b.st[1];
        if (nloc == 0u) { xcd_barrier_complete(bar, b.x, nloc, nx); b.st[0] = nloc; b.st[1] = nx; }
        const unsigned old = xb_add(&bar[XB_XSUB(b.x)], 1u);
        const unsigned gen = old / nloc;
        if (old + 1u == (gen + 1u) * nloc) {
            __builtin_amdgcn_fence(__ATOMIC_RELEASE, "agent");
            asm volatile("s_waitcnt vmcnt(0)" ::: "memory");
            const unsigned og = xb_add(&bar[XB_TOP], 1u);
            const unsigned tg = og / nx;
            if (og + 1u == (tg + 1u) * nx) xb_add(&bar[XB_TOPGEN], 1u);
            else XB_SPIN(xb_ld(&bar[XB_TOPGEN]) == tg, bar);
            __builtin_amdgcn_fence(__ATOMIC_ACQUIRE, "agent");
            xb_add(&bar[XB_XGEN(b.x)], 1u);
            asm volatile("s_waitcnt vmcnt(0)" ::: "memory");
        } else {
            XB_SPIN(xb_ld(&bar[XB_XGEN(b.x)]) == gen, bar);
            __builtin_amdgcn_fence(__ATOMIC_ACQUIRE, "agent");
            asm volatile("s_waitcnt vmcnt(0)" ::: "memory");
        }
    }
    __syncthreads();
}

constexpr int RING_OFF = 0, RING_BYTES = 137216;
constexpr int LDSCTL_OFF = RING_BYTES, MISC_OFF = LDSCTL_OFF + 320;
constexpr int LDS_BYTES = RING_BYTES + 1024;
constexpr int NWAVES = 8, NTHREADS = 512;
constexpr int CW_BAR = 4096, CW_Q = 64, CW_DCNT = 16384;

typedef unsigned u32x4_t __attribute__((ext_vector_type(4)));
typedef float f32x4_t __attribute__((ext_vector_type(4)));
typedef short bf16x8_t __attribute__((ext_vector_type(8)));

__device__ __forceinline__ void p0_transpose_item(const float* W, int ldw, int K, int col0, int k0, bf16_t* WT, int wt_row0, LAS float* scr, int lane) {
#pragma unroll 8
    for (int i = 0; i < 32; ++i) { const int kk = 2 * i + (lane >> 5); scr[kk * 33 + (lane & 31)] = W[(size_t)(k0 + kk) * ldw + col0 + (lane & 31)]; }
    asm volatile("s_waitcnt lgkmcnt(0)" ::: "memory");
    const int c = lane & 7;
#pragma unroll
    for (int j = 0; j < 4; ++j) { const int n = (lane >> 3) + 8 * j; const LAS float* s = scr + (8 * c) * 33 + n;
        u32x4_t o; o.x = pk2(s[0 * 33], s[1 * 33]); o.y = pk2(s[2 * 33], s[3 * 33]); o.z = pk2(s[4 * 33], s[5 * 33]); o.w = pk2(s[6 * 33], s[7 * 33]);
        *(u32x4_t*)(WT + (size_t)(wt_row0 + n) * K + k0 + 8 * c) = o; }
    asm volatile("s_waitcnt lgkmcnt(0)" ::: "memory");
}
__device__ __forceinline__ float wave_sum(float v) {
#pragma unroll
    for (int o = 1; o < 64; o <<= 1) v += __shfl_xor(v, o);
    return v;
}

struct Args {
    const float* x_prompt; const float* x_sample; const float* cache_k; const float* cache_v; const float* cache_logf; const int* page_table;
    const float* state_ssm; const float* state_conv; const float* w_in; const float* conv_w; const float* a_log; const float* dt_bias;
    const float* onorm_w; const float* f_bias; const float* w_out; const float* norm_w; const float* final_norm_w;
    float* out; unsigned char* ws; int ph_lo, ph_hi, li, pad;
};

__global__ void __launch_bounds__(NTHREADS, 2) mega(Args a) {
    extern __shared__ __attribute__((aligned(16))) unsigned char lds_raw[];
    LAS unsigned char* lds = (LAS unsigned char*)lds_raw;
    const int tid = threadIdx.x, lane = tid & 63, wave = __builtin_amdgcn_readfirstlane(tid >> 6);
    const int G = gridDim.x, gw = blockIdx.x * NWAVES + wave, NGW = G * NWAVES;
    unsigned char* ws = a.ws;
    for (int u = tid; u < (LDS_BYTES - LDSCTL_OFF) / 4; u += NTHREADS) ((LAS unsigned*)(lds + LDSCTL_OFF))[u] = 0u;
    __syncthreads();
    XcdBarrier bar = xcd_barrier_post((unsigned*)(ws + W_CTL) + CW_BAR + a.li * XCD_BAR_WORDS, (volatile LAS unsigned*)(lds + MISC_OFF) + 8);
    const int lo = a.ph_lo, hi = a.ph_hi;
#define IN(k) (lo <= (k) && (k) < hi)
#define BOTH(k) (IN(k) && IN((k) + 1))

    if (IN(0)) {
        bf16_t* WINT = (bf16_t*)(ws + W_WINT); bf16_t* WSM = (bf16_t*)(ws + W_WSM); bf16_t* WOUT = (bf16_t*)(ws + W_WOUT); bf16_t* HB = (bf16_t*)(ws + W_HB);
        LAS float* scr = (LAS float*)(lds + RING_OFF + wave * 16384);
        constexpr int I_IN = (D_MODEL / 64) * (4096 / 32), I_OUT = (D_MODEL / 64) * (D_MODEL / 32);
        for (int it = gw; it < I_IN + I_OUT; it += NGW) {
            if (it < I_IN) { const int kb = it / 128, nb = it % 128, n0 = 32 * nb; const int col0 = n0 < 2048 ? n0 : n0 + 8;
                p0_transpose_item(a.w_in, D_IN, D_MODEL, col0, 64 * kb, WINT, n0, scr, lane); }
            else { const int r = it - I_IN, kb = r / 32, nb = r % 32;
                p0_transpose_item(a.w_out, D_MODEL, D_MODEL, 32 * nb, 64 * kb, WOUT, 32 * nb, scr, lane); }
        }
        for (int i = blockIdx.x * NTHREADS + tid; i < 16 * D_MODEL; i += G * NTHREADS) {
            const int n = i >> 10, k = i & 1023; float v = 0.f;
            if (n < 8) v = a.w_in[(size_t)k * D_IN + C_BG + n]; else if (n < 12) v = a.w_in[(size_t)k * D_IN + C_FF + (n - 8)];
            WSM[i] = (bf16_t)f2bf(v);
        }
        for (int m = gw; m < MT; m += NGW) {
            const f32x4_t* xr = (const f32x4_t*)xrow(a.x_prompt, a.x_sample, m) + lane;
            const f32x4_t* wr4 = (const f32x4_t*)a.norm_w + lane;
            f32x4_t v[4]; float s = 0.f;
#pragma unroll
            for (int j = 0; j < 4; ++j) { v[j] = xr[64 * j]; s += (v[j].x * v[j].x + v[j].y * v[j].y) + (v[j].z * v[j].z + v[j].w * v[j].w); }
            const float rstd = rsqrtf(wave_sum(s) * (1.f / D_MODEL) + 1e-6f);
            unsigned long long* o8 = (unsigned long long*)(HB + (size_t)m * D_MODEL) + lane;
#pragma unroll
            for (int j = 0; j < 4; ++j) { const f32x4_t w4 = wr4[64 * j];
                o8[64 * j] = (unsigned long long)pk2(v[j].x * rstd * w4.x, v[j].y * rstd * w4.y) | ((unsigned long long)pk2(v[j].z * rstd * w4.z, v[j].w * rstd * w4.w) << 32); }
        }
        if (BOTH(0)) xcd_barrier(bar);
    }

    if (IN(1)) {
        bf16_t* WINT = (bf16_t*)(ws + W_WINT); bf16_t* WSM = (bf16_t*)(ws + W_WSM); bf16_t* HB = (bf16_t*)(ws + W_HB);
        bf16_t* QKVG = (bf16_t*)(ws + W_QKVG); bf16_t* ZG = (bf16_t*)(ws + W_ZG); bf16_t* ZF = (bf16_t*)(ws + W_ZF);
        bf16_t* QFP = (bf16_t*)(ws + W_QFP); bf16_t* KFP = (bf16_t*)(ws + W_KFP); bf16_t* VFP = (bf16_t*)(ws + W_VFP); bf16_t* QFS = (bf16_t*)(ws + W_QFS);
        float* BETA = (float*)(ws + W_BETA); float* GG = (float*)(ws + W_G); float* LOGF = (float*)(ws + W_LOGF);
        pg8::Gemm g{HB, WINT, MT, 4096, D_MODEL}; pg8::StaticOrder S; S.init(MT, 4096, G, (int)blockIdx.x);
        pg8::EpiProj E{QKVG, ZG, ZF, QFP, KFP, VFP, QFS, a.out};
        pg8::gemm_phase<pg8::EpiProj, pg8::StaticOrder, false>(lds + RING_OFF, g, S, E, nullptr);
        for (int tile = gw; tile < MT / 16; tile += NGW) {
            const int row0 = tile * 16;
            f32x4_t acc = {0.f, 0.f, 0.f, 0.f};
            const bf16_t* ap = HB + (size_t)(row0 + (lane & 15)) * D_MODEL + 8 * (lane >> 4);
            const bf16_t* bp = WSM + (size_t)(lane & 15) * D_MODEL + 8 * (lane >> 4);
#pragma unroll 8
            for (int kk = 0; kk < 32; ++kk) { const bf16x8_t av = *(const bf16x8_t*)(ap + 32 * kk), bv = *(const bf16x8_t*)(bp + 32 * kk);
                acc = __builtin_amdgcn_mfma_f32_16x16x32_bf16(av, bv, acc, 0, 0, 0); }
            const int col = lane & 15;
#pragma unroll
            for (int j = 0; j < 4; ++j) {
                const int row = row0 + 4 * (lane >> 4) + j; const float v = acc[j];
                if (col < 4) BETA[row * 4 + col] = sigmoidf_(v);
                else if (col < 8) GG[row * 4 + (col - 4)] = -expf(a.a_log[col - 4]) * softplusf_(v + a.dt_bias[col - 4]);
                else if (col < 12) { const float lf = logsigmoidf_(v + a.f_bias[col - 8]); LOGF[row * 4 + (col - 8)] = lf;
                    if (row < MP) a.out[O_LP + (size_t)row * 4 + (col - 8)] = lf; else a.out[O_LS + (size_t)(row - MP) * 4 + (col - 8)] = lf; }
            }
        }
        if (BOTH(1)) xcd_barrier(bar);
    }

    if (IN(2)) {
        const bf16_t* QKVG = (const bf16_t*)(ws + W_QKVG);
        const float* LOGF = (const float*)(ws + W_LOGF); float* GPL = (float*)(ws + W_GPL);
        for (int ch = gw; ch < BATCH * 4; ch += NGW) {
            const int b = ch >> 2, h = ch & 3; float v[32]; float run = 0.f;
#pragma unroll
            for (int i = 0; i < 32; ++i) { run += LOGF[((size_t)b * SEQ + 32 * lane + i) * 4 + h]; v[i] = run; }
            float incl = run;
#pragma unroll
            for (int o = 1; o < 64; o <<= 1) { const float t2 = __shfl_up(incl, o); if (lane >= o) incl += t2; }
            const float excl = incl - run;
#pragma unroll
            for (int i = 0; i < 32; ++i) GPL[(size_t)ch * SEQ + 32 * lane + i] = -(v[i] + excl) * 1.4426950408889634f;
        }
        const float* BETA = (const float*)(ws + W_BETA); const float* GG = (const float*)(ws + W_G);
        const int half2 = tid >> 8, t8 = tid & 255;
        for (int ci = blockIdx.x * 2 + half2; ci < BATCH * 4 * 32; ci += 2 * G)
            gdn::chunk_item(QKVG, a.conv_w, BETA, GG, (bf16_t*)(ws + W_WN), (bf16_t*)(ws + W_QD), (bf16_t*)(ws + W_KDT), (bf16_t*)(ws + W_QKM), (float*)(ws + W_UT), (float*)(ws + W_GL),
                            ci >> 7, (ci >> 5) & 3, ci & 31, lds + RING_OFF + half2 * gdn::L_HALF, t8);
        if (BOTH(2)) xcd_barrier(bar);
    }

    if (IN(3)) {
        bf16_t* OMIX = (bf16_t*)(ws + W_OMIX);
        const int sub = a.pad;
        if (blockIdx.x < 32 && (sub == 0 || (sub & 1))) {
            const int b = blockIdx.x >> 2, h = blockIdx.x & 3;
            gdn::scan_head((const bf16_t*)(ws + W_WN), (const bf16_t*)(ws + W_QD), (const bf16_t*)(ws + W_KDT), (const bf16_t*)(ws + W_QKM), (const float*)(ws + W_UT), (const float*)(ws + W_GL),
                           (const bf16_t*)(ws + W_ZG), a.onorm_w, OMIX, a.out + O_SSMP + (size_t)blockIdx.x * 128 * 128, b, h, lds + RING_OFF);
        }
        else if (blockIdx.x >= 32 && blockIdx.x < 160 && (sub == 0 || (sub & 2))) {
            const int it = blockIdx.x - 32, bh = it >> 2, x = it & 3, b = bh >> 2, h = bh & 3;
            const bf16_t* Qh = (const bf16_t*)(ws + W_QFP) + (size_t)bh * SEQ * HD; const bf16_t* Kh = (const bf16_t*)(ws + W_KFP) + (size_t)bh * SEQ * HD;
            const bf16_t* Vh = (const bf16_t*)(ws + W_VFP) + (size_t)bh * SEQ * HD;
            const int pA = x * 256, pB = (7 - x) * 256;
            fa::BlockRef A{Qh + (size_t)pA * HD, Kh, Vh, OMIX + ((size_t)b * SEQ + pA) * 1024 + 512 + h * 128, (const bf16_t*)(ws + W_ZF) + ((size_t)b * SEQ + pA) * 512 + h * 128, pA};
            fa::BlockRef B{Qh + (size_t)pB * HD, Kh, Vh, OMIX + ((size_t)b * SEQ + pB) * 1024 + 512 + h * 128, (const bf16_t*)(ws + W_ZF) + ((size_t)b * SEQ + pB) * 512 + h * 128, pB};
            fa::Seam Sm;
            fa::fox_prime(A, (const float*)(ws + W_GPL) + (size_t)bh * SEQ, (char*)lds_raw + RING_OFF, Sm);
            fa::fox_block(A, B, (char*)lds_raw + RING_OFF, Sm);
            fa::fox_block(B, B, (char*)lds_raw + RING_OFF, Sm);
        }
        __syncthreads();
        {
            const int half2 = tid >> 8, t8 = tid & 255;
            volatile LAS unsigned* MISC = (volatile LAS unsigned*)(lds + MISC_OFF);
            HalfBar hb{(LAS unsigned*)(lds + MISC_OFF) + 16 + half2, 0u};
            LAS float* ldsh = (LAS float*)(lds + RING_OFF) + half2 * dec::LDS_FLOATS;
            unsigned* qhead = (unsigned*)(ws + W_CTL) + CW_Q + 64 * a.li;
            const bf16_t* QKVG = (const bf16_t*)(ws + W_QKVG); const float* BETA = (const float*)(ws + W_BETA); const float* GG = (const float*)(ws + W_G);
            const bf16_t* ZG = (const bf16_t*)(ws + W_ZG);
            for (;;) {
                if (t8 == 0) MISC[20 + half2] = (sub == 0 || (sub & 4)) ? __hip_atomic_fetch_add(qhead, 1u, __ATOMIC_RELAXED, __HIP_MEMORY_SCOPE_AGENT) : 0xffffu;
                hbar(hb);
                const int it = (int)MISC[20 + half2];
                if (it >= 5 * DEC_BATCH * 4) break;
                if (it < 4 * DEC_BATCH * 4) {
                    const int bh = it >> 2, split = it & 3, b = bh >> 2, h = bh & 3;
                    dec::dec_item(a.cache_k, a.cache_v, a.cache_logf, a.page_table + b * NPAGES, (const bf16_t*)(ws + W_QFS) + (size_t)bh * DEC_SEQ * HD,
                                  (const float*)(ws + W_LOGF) + (size_t)(MP + b * DEC_SEQ) * 4 + h,
                                  a.out + O_KS + (size_t)b * DEC_SEQ * 512, a.out + O_VS + (size_t)b * DEC_SEQ * 512,
                                  (const bf16_t*)(ws + W_ZF) + (size_t)(MP + b * DEC_SEQ) * 512, OMIX + (size_t)(MP + b * DEC_SEQ) * 1024, h, split,
                                  (float*)(ws + W_DPART) + (size_t)bh * 16 * 132, (unsigned*)(ws + W_CTL) + CW_DCNT + 16 * bh, ldsh, t8, hb);
                } else {
                    const int i2 = it - 4 * DEC_BATCH * 4, b = i2 >> 2, h = i2 & 3; const int row0 = MP + b * DEC_SEQ;
                    const int dv = t8 & 127, half = t8 >> 7;
                    LAS float* sm = ldsh; LAS float* sq = sm; LAS float* sk = sm + 128; LAS float* sv = sm + 256; LAS float* sp = sm + 384; LAS float* sn = sm + 640;
                    float S[64];
                    { const float* s0 = a.state_ssm + ((size_t)(b * 4 + h) * 128 + 64 * half) * 128 + dv;
#pragma unroll
                      for (int i8 = 0; i8 < 64; i8 += 8) { const float* pb = s0 + i8 * 128;
#pragma unroll
                          for (int i = 0; i < 8; ++i) S[i8 + i] = pb[i * 128];
                          asm volatile("" ::: "memory"); } }
                    for (int t = 0; t < DEC_SEQ; ++t) {
                        const int row = row0 + t;
                        for (int cc = 0; cc < 2; ++cc) { if (half == 1 && cc == 1) break;
                            const int c = half == 0 ? (cc == 0 ? h * 128 + dv : 1024 + h * 128 + dv) : 512 + h * 128 + dv;
                            float y = 0.f;
#pragma unroll
                            for (int j = 0; j < 4; ++j) { const int ts = t - 3 + j;
                                const float xv = ts >= 0 ? bf2f(QKVG[(size_t)(row0 + ts) * CONV_DIM + c]) : a.state_conv[((size_t)b * 3 + (3 + ts)) * CONV_DIM + c];
                                y = fmaf(a.conv_w[j * CONV_DIM + c], xv, y); }
                            y = siluf_(y);
                            if (half == 0) { if (cc == 0) sq[dv] = y; else sv[dv] = y; } else sk[dv] = y; }
                        hbar(hb);
                        if (t8 < 64) { float x = sq[t8] * sq[t8] + sq[t8 + 64] * sq[t8 + 64]; for (int o = 32; o >= 1; o >>= 1) x += __shfl_xor(x, o); if (t8 == 0) sn[0] = rsqrtf(x + 1e-6f) * 0.08838834764831845f; }
                        else if (t8 < 128) { const int l = t8 - 64; float x = sk[l] * sk[l] + sk[l + 64] * sk[l + 64]; for (int o = 32; o >= 1; o >>= 1) x += __shfl_xor(x, o); if (l == 0) sn[1] = rsqrtf(x + 1e-6f); }
                        hbar(hb);
                        const float qs = sn[0], ks = sn[1], al = expf(GG[row * 4 + h]), beta = BETA[row * 4 + h];
                        float p = 0.f;
#pragma unroll
                        for (int i8 = 0; i8 < 64; i8 += 8) {
#pragma unroll
                            for (int i = i8; i < i8 + 8; ++i) { S[i] *= al; p = fmaf(S[i], sk[64 * half + i] * ks, p); }
                            asm volatile("" ::: "memory"); }
                        sp[half * 128 + dv] = p;
                        hbar(hb);
                        const float r = sv[dv] - (sp[dv] + sp[128 + dv]);
                        hbar(hb);
                        float po = 0.f;
#pragma unroll
                        for (int i8 = 0; i8 < 64; i8 += 8) {
#pragma unroll
                            for (int i = i8; i < i8 + 8; ++i) { S[i] = fmaf(beta * (sk[64 * half + i] * ks), r, S[i]); po = fmaf(S[i], sq[64 * half + i] * qs, po); }
                            asm volatile("" ::: "memory"); }
                        sp[half * 128 + dv] = po;
                        hbar(hb);
                        if (t8 < 64) { const float o0 = sp[t8] + sp[128 + t8], o1 = sp[t8 + 64] + sp[128 + t8 + 64];
                            float ss = o0 * o0 + o1 * o1; for (int o = 32; o >= 1; o >>= 1) ss += __shfl_xor(ss, o);
                            const float rr = rsqrtf(ss * (1.f / 128.f) + 1e-6f);
                            const bf16_t* z = ZG + (size_t)row * 512 + h * 128; bf16_t* om = OMIX + (size_t)row * 1024 + h * 128;
                            om[t8] = (bf16_t)f2bf(o0 * rr * a.onorm_w[t8] * siluf_(bf2f(z[t8])));
                            om[t8 + 64] = (bf16_t)f2bf(o1 * rr * a.onorm_w[t8 + 64] * siluf_(bf2f(z[t8 + 64]))); }
                        hbar(hb);
                    }
                    float* so = a.out + O_SSMS + ((size_t)(b * 4 + h) * 128 + 64 * half) * 128 + dv;
#pragma unroll
                    for (int i8 = 0; i8 < 64; i8 += 8) { float* pb = so + i8 * 128;
#pragma unroll
                        for (int i = 0; i < 8; ++i) pb[i * 128] = S[i8 + i];
                        asm volatile("" ::: "memory"); }
                }
            }
        }
        xcd_barrier(bar);
    }

    if (IN(5)) {
        bf16_t* WOUT = (bf16_t*)(ws + W_WOUT); bf16_t* OMIX = (bf16_t*)(ws + W_OMIX); float* YPRE = (float*)(ws + W_YPRE); float* PART = (float*)(ws + W_PART);
        pg8::Gemm g{OMIX, WOUT, MT, D_MODEL, D_MODEL}; pg8::StaticOrder S; S.init(MT, D_MODEL, G, (int)blockIdx.x);
        pg8::EpiOut E{a.x_prompt, a.x_sample, YPRE, PART};
        pg8::gemm_phase<pg8::EpiOut, pg8::StaticOrder, false>(lds + RING_OFF, g, S, E, nullptr);
        if (BOTH(5)) xcd_barrier(bar);
    }

    if (IN(6)) {
        float* YPRE = (float*)(ws + W_YPRE); float* PART = (float*)(ws + W_PART);
        for (int m = gw; m < MT; m += NGW) {
            float p = PART[(size_t)m * 16 + (lane & 15)];
            p += __shfl_xor(p, 1); p += __shfl_xor(p, 2); p += __shfl_xor(p, 4); p += __shfl_xor(p, 8);
            const float rstd = rsqrtf(p * (1.f / D_MODEL) + 1e-6f);
            const f32x4_t* yr = (const f32x4_t*)(YPRE + (size_t)m * D_MODEL) + lane;
            const f32x4_t* wr4 = (const f32x4_t*)a.final_norm_w + lane;
            f32x4_t* o = (f32x4_t*)(m < MP ? a.out + O_YP + (size_t)m * D_MODEL : a.out + O_YS + (size_t)(m - MP) * D_MODEL) + lane;
#pragma unroll
            for (int j = 0; j < 4; ++j) o[64 * j] = yr[64 * j] * rstd * wr4[64 * j];
        }
    }
#undef IN
#undef BOTH
}

extern "C" void kernel_launch(void* const* d_in, const int* in_sizes, int n_in, void* d_out, int out_size, void* d_ws, size_t ws_size, hipStream_t stream) {
    static int grid = 0;
    if (grid == 0) {
        if (n_in != 17 || (size_t)out_size != O_END || ws_size < W_END) { fprintf(stderr, "kernel_launch: unexpected shapes\n"); grid = -1; return; }
        int dev = 0, cus = 0;
        if (hipGetDevice(&dev) != hipSuccess || hipDeviceGetAttribute(&cus, hipDeviceAttributeMultiprocessorCount, dev) != hipSuccess) { grid = -1; return; }
        if (hipFuncSetAttribute((const void*)mega, hipFuncAttributeMaxDynamicSharedMemorySize, LDS_BYTES) != hipSuccess) { fprintf(stderr, "kernel_launch: hipFuncSetAttribute failed\n"); grid = -1; return; }
        int per_cu = 0;
        if (hipOccupancyMaxActiveBlocksPerMultiprocessor(&per_cu, (const void*)mega, NTHREADS, LDS_BYTES) != hipSuccess || per_cu < 1) fprintf(stderr, "kernel_launch: occupancy query says %d\n", per_cu);
        (void)hipGetLastError();
        grid = cus;
    }
    if (grid < 0) return;
    Args a{};
    a.x_prompt = (const float*)d_in[0]; a.x_sample = (const float*)d_in[1]; a.cache_k = (const float*)d_in[2]; a.cache_v = (const float*)d_in[3]; a.cache_logf = (const float*)d_in[4];
    a.page_table = (const int*)d_in[5]; a.state_ssm = (const float*)d_in[6]; a.state_conv = (const float*)d_in[7]; a.w_in = (const float*)d_in[8]; a.conv_w = (const float*)d_in[9];
    a.a_log = (const float*)d_in[10]; a.dt_bias = (const float*)d_in[11]; a.onorm_w = (const float*)d_in[12]; a.f_bias = (const float*)d_in[13]; a.w_out = (const float*)d_in[14];
    a.norm_w = (const float*)d_in[15]; a.final_norm_w = (const float*)d_in[16]; a.out = (float*)d_out; a.ws = (unsigned char*)d_ws;
    unsigned char* ws = (unsigned char*)d_ws;
    (void)hipMemsetAsync(ws + W_CTL, 0, CTL_BYTES, stream);
    int nl = 0;
    auto launch = [&](int lo, int hi) { a.ph_lo = lo; a.ph_hi = hi; a.li = nl++; hipLaunchKernelGGL(mega, dim3(grid), dim3(NTHREADS), LDS_BYTES, stream, a); };
    launch(0, 7);
#ifdef PROBE_LO
    a.pad = PROBE_SUB; launch(PROBE_LO, PROBE_HI); a.pad = 0;
#endif
}
```
